# Optimizing an MI355X kernel written in HIP

```python
import math
import jax
import jax.numpy as jnp
from jax import lax
import numpy as np

D_MODEL = 1024
BATCH = 16
SEQ = 4096
DEPTH = 1

NORM_EPS = 1e-5

ATT_HEAD_DIM = 128
ATT_HEADS_PER_GROUP = 4
DILATED_GROUPS = ((128, 1), (512, 4), (2048, 16))
N_ATT_GROUPS = len(DILATED_GROUPS)
N_ATT_HEADS = N_ATT_GROUPS * ATT_HEADS_PER_GROUP
ATT_OUT_WIDTH = ATT_HEADS_PER_GROUP * ATT_HEAD_DIM
REL_BUCKETS = 32
REL_MAX_DIST = 2048

RET_HEADS = 4
RET_DK = 128
RET_DV = 256
RET_CHUNK = 128
ROPE_BASE = 10000.0

PROJ_SPLITS = (
    N_ATT_HEADS * ATT_HEAD_DIM, N_ATT_HEADS * ATT_HEAD_DIM, N_ATT_HEADS * ATT_HEAD_DIM,
    RET_HEADS * RET_DK, RET_HEADS * RET_DK,
    RET_HEADS * RET_DV, RET_HEADS * RET_DV,
    D_MODEL, D_MODEL,
)
PROJ_WIDTH = sum(PROJ_SPLITS)
PROJ_OFFSETS = tuple(int(v) for v in np.cumsum(PROJ_SPLITS)[:-1])

N_EXPERTS = 32
TOP_K = 4
D_EXPERT = 1024
SWIGLU_LIMIT = 7.0
SWIGLU_ALPHA = 1.702
MOE_BLOCK = 256

kernel_name = "hybrid_dilated_retention_moe_block"


def rmsnorm(x, g):
    xf = x.astype(jnp.float32)
    y = xf * lax.rsqrt(jnp.mean(xf * xf, axis=-1, keepdims=True) + NORM_EPS)
    return (y * g.astype(jnp.float32)).astype(x.dtype)


def t5_bucket(dist):
    max_exact = REL_BUCKETS // 2
    d_f = jnp.maximum(dist, 1).astype(jnp.float32)
    large = max_exact + (jnp.log(d_f / max_exact) / math.log(REL_MAX_DIST / max_exact)
                         * (REL_BUCKETS - max_exact)).astype(jnp.int32)
    large = jnp.minimum(large, REL_BUCKETS - 1)
    return jnp.where(dist < max_exact, dist, large)


def dilated_window_attention(q, k, v, rel_bias, dilation, n_steps):
    B, S, H, E = q.shape
    L = S // dilation
    nb = -(-L // n_steps)
    Lp = nb * n_steps

    def to_blocks(t):
        t = t.reshape(B, L, dilation, H, E).transpose(0, 2, 1, 3, 4)
        t = jnp.pad(t, ((0, 0), (0, 0), (0, Lp - L), (0, 0), (0, 0)))
        return t.reshape(B, dilation, nb, n_steps, H, E)

    def with_prev(t):
        prev = jnp.pad(t, ((0, 0), (0, 0), (1, 0), (0, 0), (0, 0), (0, 0)))[:, :, :-1]
        return jnp.concatenate([prev, t], axis=3)

    qb = to_blocks(q)
    kw = with_prev(to_blocks(k))
    vw = with_prev(to_blocks(v))

    qi = jnp.arange(n_steps)[:, None]
    kj = jnp.arange(2 * n_steps)[None, :]
    step_dist = qi + n_steps - kj
    band = (step_dist >= 0) & (step_dist <= n_steps)
    key_step = jnp.arange(nb)[:, None] * n_steps + kj - n_steps
    valid = band[None] & (key_step >= 0)[:, None, :]
    bias = rel_bias[t5_bucket(jnp.maximum(step_dist, 0) * dilation)]
    bias = bias.astype(jnp.float32).transpose(2, 0, 1)

    scale = E ** -0.5
    logits = jnp.einsum('brnqhe,brnkhe->brnhqk', qb, kw).astype(jnp.float32) * scale + bias
    logits = jnp.where(valid[None, None, :, None], logits, -jnp.inf)
    m = jnp.max(logits, axis=-1, keepdims=True)
    p = jnp.exp(logits - m)
    denom = jnp.sum(p, axis=-1)
    o = jnp.einsum('brnhqk,brnkhe->brnqhe', p, vw.astype(jnp.float32))
    o = o / denom.transpose(0, 1, 2, 4, 3)[..., None]
    lse = (m[..., 0] + jnp.log(denom)).transpose(0, 1, 2, 4, 3)

    o = o.reshape(B, dilation, Lp, H, E)[:, :, :L].transpose(0, 2, 1, 3, 4).reshape(B, S, H, E)
    lse = lse.reshape(B, dilation, Lp, H)[:, :, :L].transpose(0, 2, 1, 3).reshape(B, S, H)
    return o, lse


def rotary(t):
    S, E = t.shape[1], t.shape[-1]
    inv = ROPE_BASE ** (-jnp.arange(0, E, 2, dtype=jnp.float32) / E)
    ang = jnp.arange(S, dtype=jnp.float32)[:, None] * inv[None]
    cos = jnp.cos(ang)[None, :, None, :]
    sin = jnp.sin(ang)[None, :, None, :]
    tf = t.astype(jnp.float32)
    t1, t2 = tf[..., 0::2], tf[..., 1::2]
    return jnp.stack([t1 * cos - t2 * sin, t1 * sin + t2 * cos], axis=-1).reshape(t.shape)


def retention_chunkwise(q, k, v):
    B, S, H, dk = q.shape
    dv = v.shape[-1]
    C = RET_CHUNK
    nc = S // C
    log_g = jnp.log(1.0 - 2.0 ** (-5.0 - jnp.arange(H, dtype=jnp.float32)))
    idx = jnp.arange(C, dtype=jnp.float32)
    diff = idx[:, None] - idx[None, :]
    decay = jnp.where(diff >= 0, jnp.exp(jnp.maximum(diff, 0.0)[None] * log_g[:, None, None]), 0.0)
    xi = jnp.exp((idx + 1.0)[:, None] * log_g[None])
    zeta = jnp.exp((C - 1.0 - idx)[:, None] * log_g[None])
    g_chunk = jnp.exp(C * log_g)

    qc = q.reshape(B, nc, C, H, dk)
    kc = k.reshape(B, nc, C, H, dk)
    vc = v.reshape(B, nc, C, H, dv)
    scores = jnp.einsum('bnihd,bnjhd->bnhij', qc, kc) * decay
    inner = jnp.einsum('bnhij,bnjhe->bnihe', scores, vc)

    def step(R, xs):
        q_n, k_n, v_n = xs
        cross = jnp.einsum('bihd,bhde->bihe', q_n, R) * xi[None, :, :, None]
        R = R * g_chunk[None, :, None, None] + jnp.einsum('bjhd,bjhe->bhde', k_n * zeta[None, :, :, None], v_n)
        return R, cross

    R0 = jnp.zeros((B, H, dk, dv), jnp.float32)
    _, cross = lax.scan(step, R0, (qc.transpose(1, 0, 2, 3, 4), kc.transpose(1, 0, 2, 3, 4),
                                   vc.transpose(1, 0, 2, 3, 4)))
    cross = cross.transpose(1, 0, 2, 3, 4)
    return (inner + cross).reshape(B, S, H, dv)


def moe_ffn(h, w_router, b_router, w1, b1, w2, b2):
    B, S, D = h.shape
    T = B * S
    M = MOE_BLOCK
    F = D_EXPERT
    xt = h.reshape(T, D)
    logits = (xt @ w_router + b_router).astype(jnp.float32)
    top_vals, top_idx = lax.top_k(logits, TOP_K)
    gates = jax.nn.softmax(top_vals, axis=-1)

    A = T * TOP_K
    e_flat = top_idx.reshape(A)
    tok_flat = jnp.broadcast_to(jnp.arange(T, dtype=jnp.int32)[:, None], (T, TOP_K)).reshape(A)
    w_flat = gates.reshape(A)
    order = jnp.argsort(e_flat)
    e_sorted = e_flat[order]
    tok_sorted = tok_flat[order]
    w_sorted = w_flat[order]

    counts = jnp.bincount(e_flat, length=N_EXPERTS)
    padded = ((counts + M - 1) // M) * M
    start = jnp.cumsum(counts) - counts
    pend = jnp.cumsum(padded)
    pstart = pend - padded
    pos = pstart[e_sorted] + jnp.arange(A) - start[e_sorted]
    nblk = -(-A // M) + N_EXPERTS
    P = nblk * M
    buf_tok = jnp.full((P,), T, jnp.int32).at[pos].set(tok_sorted)
    buf_w = jnp.zeros((P,), jnp.float32).at[pos].set(w_sorted)
    blk_expert = jnp.minimum(jnp.searchsorted(pend, jnp.arange(nblk) * M, side='right'), N_EXPERTS - 1)

    x_pad = jnp.concatenate([xt, jnp.zeros((1, D), xt.dtype)], axis=0)

    def expert_block(args):
        tok, e = args
        xb = x_pad[tok]
        gu = xb @ w1[e] + b1[e]
        gate = jnp.minimum(gu[:, :F], SWIGLU_LIMIT)
        up = jnp.clip(gu[:, F:], -SWIGLU_LIMIT, SWIGLU_LIMIT)
        act = (up + 1.0) * gate * jax.nn.sigmoid(SWIGLU_ALPHA * gate)
        return act @ w2[e] + b2[e]

    yb = lax.map(expert_block, (buf_tok.reshape(nblk, M), blk_expert))
    y = yb.reshape(P, D) * buf_w[:, None].astype(yb.dtype)
    out = jnp.zeros((T + 1, D), yb.dtype).at[buf_tok].add(y)[:T]
    return out.reshape(B, S, D).astype(h.dtype)


def setup_inputs(seed: int = 0) -> dict:
    key = jax.random.key(seed)
    ks = jax.random.split(key, 16)
    D = D_MODEL
    nrm = jax.random.normal
    ret_w = RET_HEADS * RET_DV
    return {
        "x": nrm(ks[0], (BATCH, SEQ, D), jnp.float32),
        "norm_mix_g": 1.0 + 0.02 * nrm(ks[1], (DEPTH, D), jnp.float32),
        "w_in": nrm(ks[2], (DEPTH, D, PROJ_WIDTH), jnp.float32) * D ** -0.5,
        "rel_bias": 0.5 * nrm(ks[3], (REL_BUCKETS, N_ATT_HEADS), jnp.float32),
        "w_att_branch": nrm(ks[4], (DEPTH, ATT_OUT_WIDTH, D), jnp.float32) * ATT_OUT_WIDTH ** -0.5,
        "w_ret_branch": nrm(ks[5], (DEPTH, ret_w, D), jnp.float32) * ret_w ** -0.5,
        "w_out": nrm(ks[6], (DEPTH, D, D), jnp.float32) * D ** -0.5,
        "norm_ffn_g": 1.0 + 0.02 * nrm(ks[7], (DEPTH, D), jnp.float32),
        "w_router": nrm(ks[8], (DEPTH, D, N_EXPERTS), jnp.float32) * D ** -0.5,
        "b_router": 0.01 * nrm(ks[9], (DEPTH, N_EXPERTS), jnp.float32),
        "w1": nrm(ks[10], (DEPTH, N_EXPERTS, D, 2 * D_EXPERT), jnp.float32) * D ** -0.5,
        "b1": 0.01 * nrm(ks[11], (DEPTH, N_EXPERTS, 2 * D_EXPERT), jnp.float32),
        "w2": nrm(ks[12], (DEPTH, N_EXPERTS, D_EXPERT, D), jnp.float32) * D_EXPERT ** -0.5,
        "b2": 0.01 * nrm(ks[13], (DEPTH, N_EXPERTS, D), jnp.float32),
        "norm_final_g": 1.0 + 0.02 * nrm(ks[14], (D,), jnp.float32),
    }


def reference(x, norm_mix_g, w_in, rel_bias, w_att_branch, w_ret_branch, w_out, norm_ffn_g,
              w_router, b_router, w1, b1, w2, b2, norm_final_g):
    B, S, D = x.shape
    for layer in range(DEPTH):
        h = rmsnorm(x, norm_mix_g[layer])
        proj = h @ w_in[layer]
        q_a, k_a, v_a, q_r, k_r, v_r, g_r, gate_a, gate_r = jnp.split(proj, PROJ_OFFSETS, axis=-1)

        q_a = q_a.reshape(B, S, N_ATT_HEADS, ATT_HEAD_DIM)
        k_a = k_a.reshape(B, S, N_ATT_HEADS, ATT_HEAD_DIM)
        v_a = v_a.reshape(B, S, N_ATT_HEADS, ATT_HEAD_DIM)
        outs, lses = [], []
        for g, (window, dilation) in enumerate(DILATED_GROUPS):
            hs = slice(g * ATT_HEADS_PER_GROUP, (g + 1) * ATT_HEADS_PER_GROUP)
            o_g, lse_g = dilated_window_attention(q_a[:, :, hs], k_a[:, :, hs], v_a[:, :, hs],
                                                  rel_bias[:, hs], dilation, window // dilation)
            outs.append(o_g)
            lses.append(lse_g)
        wts = jax.nn.softmax(jnp.stack(lses, axis=0), axis=0)
        att = jnp.sum(wts[..., None] * jnp.stack(outs, axis=0), axis=0)
        att = att.reshape(B, S, ATT_OUT_WIDTH).astype(x.dtype)

        q_r = rotary(q_r.reshape(B, S, RET_HEADS, RET_DK))
        k_r = rotary(k_r.reshape(B, S, RET_HEADS, RET_DK)) * RET_DK ** -0.5
        v_r = v_r.reshape(B, S, RET_HEADS, RET_DV).astype(jnp.float32)
        ret = retention_chunkwise(q_r, k_r, v_r)
        mu = jnp.mean(ret, axis=-1, keepdims=True)
        var = jnp.mean(jnp.square(ret - mu), axis=-1, keepdims=True)
        ret = (ret - mu) * lax.rsqrt(var + NORM_EPS)
        ret = (jax.nn.silu(g_r.astype(jnp.float32)) * ret.reshape(B, S, RET_HEADS * RET_DV)).astype(x.dtype)

        merged = (jax.nn.sigmoid(gate_a) * (att @ w_att_branch[layer])
                  + jax.nn.sigmoid(gate_r) * (ret @ w_ret_branch[layer]))
        x = x + merged @ w_out[layer]

        hf = rmsnorm(x, norm_ffn_g[layer])
        x = x + moe_ffn(hf, w_router[layer], b_router[layer], w1[layer], b1[layer], w2[layer], b2[layer])
    return rmsnorm(x, norm_final_g)
```

```cpp
#include <hip/hip_runtime.h>
#include <cstdio>
#include <cstdint>

#ifndef MK_PER_PHASE
#define MK_PER_PHASE 0
#endif

#define GAS __attribute__((address_space(1)))
#define LAS __attribute__((address_space(3)))
typedef unsigned short bf16_t;
typedef short bf16x8 __attribute__((ext_vector_type(8)));
typedef short s16x4 __attribute__((ext_vector_type(4)));
typedef float f32x4 __attribute__((ext_vector_type(4)));
typedef float f32x2 __attribute__((ext_vector_type(2)));
typedef unsigned u32x4 __attribute__((ext_vector_type(4)));
typedef unsigned u32x2 __attribute__((ext_vector_type(2)));
typedef int i32x4 __attribute__((ext_vector_type(4)));

constexpr int T_TOK = 65536, DM = 1024, SEQ = 4096, NB = 16;
constexpr int N_ATT = 4608, N_RET = 3072, N_GATE = 2048, PROJ_W = 9728;
constexpr int NEXP = 32, TOPK = 4, DEXP = 1024;
constexpr int HALF_TOK = 32768, HALF_ROWS = 139264, HALF_TILES = 544;
constexpr float NORM_EPS = 1e-5f;
constexpr float LOG2E = 1.4426950408889634f;

constexpr size_t MiB = 1u << 20;
constexpr size_t WS_CTL = 0, CTL_BYTES = 1 * MiB;
constexpr size_t WS_ROPE = 1 * MiB;
constexpr size_t WS_BIAS = 3 * MiB;
constexpr size_t WS_WRL = 3 * MiB + 65536;
constexpr size_t WS_RSTD = 4 * MiB;
constexpr size_t WS_ASG = 5 * MiB;
constexpr size_t WS_SORT = 9 * MiB;
constexpr size_t WS_TILE = 13 * MiB;
constexpr size_t WS_LSE = 14 * MiB;
constexpr size_t WS_WATT = 16 * MiB;
constexpr size_t WS_WRET = 17 * MiB;
constexpr size_t WS_WOUT = 19 * MiB;
constexpr size_t WS_WIN = 21 * MiB;
constexpr size_t WS_W1 = 40 * MiB;
constexpr size_t WS_SW1 = 104 * MiB;
constexpr size_t WS_WINQ = 112 * MiB;
constexpr size_t WS_SWIN = 124 * MiB;
constexpr size_t WS_RS0 = 4 * MiB + 512 * 1024;
constexpr size_t WS_W2 = 168 * MiB;
constexpr size_t WS_SW2 = 200 * MiB;
constexpr float ACT_STEP = 12.0f / 127.0f;
constexpr size_t WS_DYN = 232 * MiB;
constexpr size_t DY_ATTBUF = WS_DYN;
constexpr size_t DY_ATT = WS_DYN + 720 * MiB;
constexpr size_t DY_RETBUF = WS_DYN;
constexpr size_t DY_GATEBUF = WS_DYN + 384 * MiB;
constexpr size_t DY_M1 = WS_DYN;
constexpr size_t DY_MERGED = WS_DYN + 128 * MiB;
constexpr size_t DY_X1B = WS_DYN;
constexpr size_t DY_ACT = WS_DYN + 128 * MiB;
constexpr size_t DY_Y = WS_DYN + 400 * MiB;
constexpr size_t WS_END = WS_DYN + 792 * MiB;
static_assert(DY_Y + (size_t)HALF_ROWS * 2048 <= WS_END, "ws map");
static_assert(DY_ATTBUF + (size_t)T_TOK * N_ATT * 2 <= DY_ATT, "ws map");
constexpr size_t DO_HB = 0, DO_SR = 0, DO_RETN = 128 * MiB, DO_HBQ = 128 * MiB;

constexpr int CW_BAR = 1024;
constexpr int CW_GCNT = 8192;

constexpr int LDS_MAIN = 131072;
constexpr int LDS_AUX = LDS_MAIN;
constexpr int LDS_MISC = LDS_MAIN + 7168;
constexpr int LDS_BYTES = LDS_MAIN + 8192;

__device__ __forceinline__ float bf2f(unsigned short b) { return __uint_as_float(((unsigned)b) << 16); }
typedef __bf16 bf16x2_t __attribute__((ext_vector_type(2)));
__device__ __forceinline__ unsigned pk2(float lo, float hi) { const f32x2 v = {lo, hi}; const bf16x2_t b = __builtin_convertvector(v, bf16x2_t); return __builtin_bit_cast(unsigned, b); }
__device__ __forceinline__ float bflo(unsigned w) { return __uint_as_float(w << 16); }
__device__ __forceinline__ float bfhi(unsigned w) { return __uint_as_float(w & 0xffff0000u); }
__device__ __forceinline__ float fast_exp2(float x) { return __builtin_amdgcn_exp2f(x); }
__device__ __forceinline__ float fast_rcp(float x) { return __builtin_amdgcn_rcpf(x); }
__device__ __forceinline__ float sigmoidf_(float x) { return fast_rcp(1.0f + fast_exp2(-x * LOG2E)); }
__device__ __forceinline__ float wave_sum(float v) {
#pragma unroll
    for (int o = 1; o < 64; o <<= 1) v += __shfl_xor(v, o);
    return v;
}
#define LDS_WAIT() asm volatile("s_waitcnt lgkmcnt(0)" ::: "memory")
#define VM_WAIT() asm volatile("s_waitcnt vmcnt(0)" ::: "memory")

__device__ __forceinline__ unsigned off_b(unsigned row, unsigned ch) { return 256u * row + 16u * (ch ^ (((row & 3u) << 2) | ((row >> 2) & 3u))); }
__device__ __forceinline__ s16x4 tr_read(const LAS unsigned char* p) { return __builtin_amdgcn_ds_read_tr16_b64_v4i16((LAS s16x4*)p); }
__device__ __forceinline__ bf16x8 cat8(s16x4 a, s16x4 b) { return __builtin_shufflevector(a, b, 0, 1, 2, 3, 4, 5, 6, 7); }

#define XB_TMO      128
#define XB_XCNT(j)  (256  + 64 * (j))
#define XB_XSUB(j)  (1280 + 64 * (j))
#define XB_XGEN(j)  (2304 + 64 * (j))
#define XB_TOP      3328
#define XB_TOPGEN   3392
#define XCD_BAR_WORDS 3456
#define XB_SPIN_CAP (1u << 18)
__device__ __forceinline__ unsigned xb_ld(unsigned* p)              { return __hip_atomic_load(p, __ATOMIC_RELAXED, __HIP_MEMORY_SCOPE_AGENT); }
__device__ __forceinline__ unsigned xb_add(unsigned* p, unsigned v) { return __hip_atomic_fetch_add(p, v, __ATOMIC_RELAXED, __HIP_MEMORY_SCOPE_AGENT); }
__device__ __forceinline__ unsigned xb_xcc_id() { return (unsigned)__builtin_amdgcn_s_getreg((3 << 11) | 20) & 0xFu; }
#define XB_SPIN(cond, bar) do { unsigned _sp = 0; while (cond) { __builtin_amdgcn_s_sleep(1); \
    if ((++_sp & 255u) == 0u) { if (xb_ld(&(bar)[XB_TMO])) break; if (_sp > XB_SPIN_CAP) { atomicAdd(&(bar)[XB_TMO], 1u); break; } } } } while (0)
struct XcdBarrier { unsigned* bar; unsigned x; volatile LAS unsigned* st; };
__device__ __forceinline__ XcdBarrier xcd_barrier_post(unsigned* bar, volatile LAS unsigned* st) {
    XcdBarrier b; b.bar = bar; b.x = xb_xcc_id(); b.st = st;
    if (threadIdx.x == 0) (void)xb_add(&bar[XB_XCNT(b.x)], 1u);
    return b;
}
__device__ __forceinline__ void xcd_barrier_complete(unsigned* bar, unsigned x, unsigned& nloc, unsigned& nx) {
    const unsigned G = gridDim.x * gridDim.y * gridDim.z;
    unsigned sum, cnt, mine, sp = 0u;
    for (;;) {
        sum = 0u; cnt = 0u; mine = 0u;
#pragma unroll
        for (unsigned j = 0; j < 16; ++j) { const unsigned c = xb_ld(&bar[XB_XCNT(j)]); sum += c; cnt += (c > 0u) ? 1u : 0u; mine = (j == x) ? c : mine; }
        if (sum == G) break;
        __builtin_amdgcn_s_sleep(1);
        if ((++sp & 255u) == 0u) { if (xb_ld(&bar[XB_TMO])) break; if (sp > XB_SPIN_CAP) { atomicAdd(&bar[XB_TMO], 1u); break; } }
    }
    nloc = mine > 0u ? mine : 1u; nx = cnt > 0u ? cnt : 1u;
}
__device__ __forceinline__ void xcd_barrier(const XcdBarrier& b) {
    asm volatile("s_waitcnt vmcnt(0)" ::: "memory");
    __syncthreads();
    if (threadIdx.x == 0) {
        unsigned* bar = b.bar;
        __builtin_amdgcn_s_waitcnt(0);
        unsigned nloc = b.st[0], nx = b.st[1];
        if (nloc == 0u) { xcd_barrier_complete(bar, b.x, nloc, nx); b.st[0] = nloc; b.st[1] = nx; }
        const unsigned old = xb_add(&bar[XB_XSUB(b.x)], 1u);
        const unsigned gen = old / nloc;
        if (old + 1u == (gen + 1u) * nloc) {
            __builtin_amdgcn_fence(__ATOMIC_RELEASE, "agent");
            asm volatile("s_waitcnt vmcnt(0)" ::: "memory");
            const unsigned og = xb_add(&bar[XB_TOP], 1u);
            const unsigned tg = og / nx;
            if (og + 1u == (tg + 1u) * nx) xb_add(&bar[XB_TOPGEN], 1u);
            else XB_SPIN(xb_ld(&bar[XB_TOPGEN]) == tg, bar);
            __builtin_amdgcn_fence(__ATOMIC_ACQUIRE, "agent");
            xb_add(&bar[XB_XGEN(b.x)], 1u);
            asm volatile("s_waitcnt vmcnt(0)" ::: "memory");
        } else {
            XB_SPIN(xb_ld(&bar[XB_XGEN(b.x)]) == gen, bar);
            __builtin_amdgcn_fence(__ATOMIC_ACQUIRE, "agent");
            asm volatile("s_waitcnt vmcnt(0)" ::: "memory");
        }
    }
    __syncthreads();
}

namespace pg8 {
constexpr int BM = 256, BK = 64, HALF = 128, HTB = HALF * BK * 2, STAGE_BYTES = 8 * HTB, NXCD = 8, WGM = 8;
__device__ __forceinline__ int lds_byte(int r, int c) { const int st = (r >> 4) * 2 + (c >> 5), rr = r & 15, cc = c & 31, ob = rr * 64 + cc * 2; return st * 1024 + (ob ^ (((ob >> 9) & 1) << 5)); }
__device__ __forceinline__ void stage_rc(int b, int& R, int& C) { const int st = b / 1024, sb = b % 1024, swz = sb ^ (((sb >> 9) & 1) << 5); R = (st >> 1) * 16 + swz / 64; C = (st & 1) * 32 + (swz % 64) / 2; }
__device__ __forceinline__ int perm32(int rho) { const int n = rho >> 4, i = rho & 15; return 8 * (i >> 2) + 4 * n + (i & 3); }
struct Unit { int pm, pn, e; };

__device__ __forceinline__ bool unit_of(long L, int nM, int nN, Unit& u) {
    const int nwg = nM * nN; if (L >= nwg) return false;
    int wgid = (int)L; { const int q = nwg / NXCD, r = nwg % NXCD, xcd = wgid % NXCD, off = wgid / NXCD; wgid = (xcd < r ? xcd * (q + 1) : r * (q + 1) + (xcd - r) * q) + off; }
    const int nig = WGM * nN, gid = wgid / nig, fm = gid * WGM, gsz = (nM - fm) < WGM ? (nM - fm) : WGM;
    u.pm = fm + ((wgid % nig) % gsz); u.pn = (wgid % nig) / gsz; u.e = 0; return true;
}
struct SchedDense {
    int nM, nN, G, c, K; const char* Bt;
    __device__ __forceinline__ bool next(int i, Unit& u) const { return unit_of((long)i * G + c, nM, nN, u); }
    __device__ __forceinline__ const char* bbase(const Unit& u) const { return Bt + (size_t)u.pn * 256 * K * 2; }
    __device__ __forceinline__ void aoff(const Unit& u, const int (&R)[2], const int (&C)[2], unsigned (&v)[2][2]) const {
#pragma unroll
        for (int h = 0; h < 2; ++h)
#pragma unroll
            for (int i = 0; i < 2; ++i) v[h][i] = (unsigned)((u.pm * 256 + h * 128 + R[i]) * K + C[i]) * 2u;
    }
};
struct SchedMoE {
    int nM, nN, G, c, K; const char* Bt; size_t estride; const int* tile_expert; const int* rowidx;
    __device__ __forceinline__ bool next(int i, Unit& u) const { if (!unit_of((long)i * G + c, nM, nN, u)) return false; u.e = __builtin_amdgcn_readfirstlane(tile_expert[u.pm]); return true; }
    __device__ __forceinline__ const char* bbase(const Unit& u) const { return Bt + (size_t)u.e * estride + (size_t)u.pn * 256 * K * 2; }
    __device__ __forceinline__ void aoff(const Unit& u, const int (&R)[2], const int (&C)[2], unsigned (&v)[2][2]) const {
#pragma unroll
        for (int h = 0; h < 2; ++h)
#pragma unroll
            for (int i = 0; i < 2; ++i) { const int r = u.pm * 256 + h * 128 + R[i]; const int src = rowidx ? rowidx[r] : r; v[h][i] = (unsigned)(src * K + C[i]) * 2u; }
    }
};

template <bool I8> struct AccSel { typedef f32x4 T; };
template <> struct AccSel<true> { typedef i32x4 T; };
template <class Epi, class Sched, bool I8 = false>
__device__ __forceinline__ void gemm_phase(LAS unsigned char* lds, const char* gA, const Sched& S, const Epi& E) {
    typedef typename AccSel<I8>::T acc_t;
    const int tid = threadIdx.x, wid = __builtin_amdgcn_readfirstlane(tid >> 6), lane = tid & 63, wr = wid >> 2, wc = wid & 3, fr = lane & 15, fq = lane >> 4;
    const int K = S.K, nt = K / BK;
    int Rr[2], Cc[2]; unsigned voffB[2];
#pragma unroll
    for (int i = 0; i < 2; ++i) { int R, C; stage_rc(tid * 16 + i * 8192, R, C); Rr[i] = R; Cc[i] = C; const int Rb = (R & ~31) + perm32(R & 31); voffB[i] = (unsigned)(Rb * K + C) * 2u; }
    const size_t kstep = (size_t)(BK * 2);
    const size_t hstep = (size_t)HALF * K * 2;
    const unsigned ldsw = (unsigned)wid * 1024u;
    const int aoff = lds_byte(wr * 64 + fr, fq * 8), boff = lds_byte(wc * 32 + fr, fq * 8);
#define PG8_SA(b, h) (((b) * 2 + (h)) * HTB)
#define PG8_SB(b, h) ((4 + (b) * 2 + (h)) * HTB)
#define PG8_STAGE_B(bufoff, gbase) do { _Pragma("unroll") for (int _i = 0; _i < 2; ++_i) \
        __builtin_amdgcn_global_load_lds((const unsigned*)((const char*)(gbase) + voffB[_i]), (LAS unsigned*)(lds + (bufoff) + ldsw + _i * 8192), 16, 0, 0); } while (0)
#define PG8_STAGE_A(bufoff, gbase, vv) do { _Pragma("unroll") for (int _i = 0; _i < 2; ++_i) \
        __builtin_amdgcn_global_load_lds((const unsigned*)((const char*)(gbase) + (vv)[_i]), (LAS unsigned*)(lds + (bufoff) + ldsw + _i * 8192), 16, 0, 0); } while (0)
#define PG8_LDA(dst, b, h) do { _Pragma("unroll") for (int m = 0; m < 4; ++m) _Pragma("unroll") for (int k = 0; k < 2; ++k) dst[m][k] = *(const LAS bf16x8*)(lds + PG8_SA(b, h) + aoff + m * 2048 + k * 1024); } while (0)
#define PG8_LDB(dst, b, h) do { _Pragma("unroll") for (int n = 0; n < 2; ++n) _Pragma("unroll") for (int k = 0; k < 2; ++k) dst[n][k] = *(const LAS bf16x8*)(lds + PG8_SB(b, h) + boff + n * 2048 + k * 1024); } while (0)
#define PG8_MMA(ai, bj, At, Bt) do { __builtin_amdgcn_s_setprio(1); _Pragma("unroll") for (int m = 0; m < 4; ++m) _Pragma("unroll") for (int n = 0; n < 2; ++n) _Pragma("unroll") for (int k = 0; k < 2; ++k) { \
        if constexpr (I8) acc[ai][bj][m][n] = __builtin_amdgcn_mfma_i32_16x16x64_i8(__builtin_bit_cast(i32x4, Bt[n][k]), __builtin_bit_cast(i32x4, At[m][k]), acc[ai][bj][m][n], 0, 0, 0); \
        else acc[ai][bj][m][n] = __builtin_amdgcn_mfma_f32_16x16x32_bf16(Bt[n][k], At[m][k], acc[ai][bj][m][n], 0, 0, 0); } __builtin_amdgcn_s_setprio(0); } while (0)
#define PG8_WAIT_V(n) asm volatile("s_waitcnt vmcnt(" #n ")" ::: "memory")
#define PG8_WAIT_L(n) asm volatile("s_waitcnt lgkmcnt(" #n ")" ::: "memory")
#define PG8_BAR __builtin_amdgcn_s_barrier()
#define PG8_SCHED __builtin_amdgcn_sched_barrier(0)
    Unit cur, nxt; int ui = 0;
    if (!S.next(0, cur)) return;
    const int ntm = nt - 1;
    int rc = (cur.pm + 2 * cur.pn) & ntm, rn = rc;
    acc_t acc[2][2][4][2];
#pragma unroll
    for (int a = 0; a < 2; ++a)
#pragma unroll
        for (int b = 0; b < 2; ++b)
#pragma unroll
            for (int m = 0; m < 4; ++m)
#pragma unroll
                for (int n = 0; n < 2; ++n) acc[a][b][m][n] = (acc_t){0, 0, 0, 0};
    bf16x8 At[4][2], B0[2][2], B1[2][2];
    unsigned vc[2][2], vn[2][2];
    S.aoff(cur, Rr, Cc, vc);
    const char* cB = S.bbase(cur);
    { const size_t k0 = (size_t)rc * kstep, k1 = (size_t)((rc + 1) & ntm) * kstep;
    PG8_STAGE_B(PG8_SB(0, 0), cB + k0); PG8_STAGE_B(PG8_SB(0, 1), cB + hstep + k0); PG8_STAGE_A(PG8_SA(0, 0), gA + k0, vc[0]); PG8_STAGE_A(PG8_SA(0, 1), gA + k0, vc[1]);
    PG8_STAGE_B(PG8_SB(1, 0), cB + k1); PG8_STAGE_B(PG8_SB(1, 1), cB + hstep + k1); PG8_STAGE_A(PG8_SA(1, 0), gA + k1, vc[0]); }
    if (wr == 1) PG8_BAR;
    PG8_WAIT_V(8); PG8_BAR; PG8_BAR;
    for (;;) {
        const bool has_next = S.next(ui + 1, nxt);
        const char* nB = cB;
        if (has_next) { S.aoff(nxt, Rr, Cc, vn); nB = S.bbase(nxt); rn = (nxt.pm + 2 * nxt.pn) & ntm; }
        else { rn = rc;
#pragma unroll
            for (int h = 0; h < 2; ++h)
#pragma unroll
                for (int i = 0; i < 2; ++i) vn[h][i] = vc[h][i];
        }
        for (int t = 0; t < nt; t += 2) {
            const bool last = (t == nt - 2);
            const size_t ko1 = (size_t)((rc + t + 1) & ntm) * kstep;
            const size_t ko2 = (size_t)(last ? rn : ((rc + t + 2) & ntm)) * kstep, ko3 = (size_t)(last ? ((rn + 1) & ntm) : ((rc + t + 3) & ntm)) * kstep;
            const char* a1 = gA + ko1;
            const char* a2 = gA + ko2;
            const char* a3 = gA + ko3;
            unsigned v2[2][2];
#pragma unroll
            for (int h = 0; h < 2; ++h)
#pragma unroll
                for (int i = 0; i < 2; ++i) v2[h][i] = last ? vn[h][i] : vc[h][i];
            const char* bb = last ? nB : cB;
            PG8_LDB(B0, 0, 0); PG8_LDB(B1, 0, 1); PG8_LDA(At, 0, 0); PG8_STAGE_A(PG8_SA(1, 1), a1, vc[1]);
            PG8_WAIT_V(8); PG8_WAIT_L(0); PG8_BAR; PG8_SCHED; PG8_MMA(0, 0, At, B0); PG8_MMA(0, 1, At, B1); PG8_BAR; PG8_SCHED;
            PG8_LDA(At, 0, 1); PG8_STAGE_B(PG8_SB(0, 0), bb + ko2); PG8_STAGE_B(PG8_SB(0, 1), bb + ko2 + hstep); PG8_STAGE_A(PG8_SA(0, 0), a2, v2[0]);
            PG8_WAIT_V(8); PG8_WAIT_L(0); PG8_BAR; PG8_SCHED; PG8_MMA(1, 0, At, B0); PG8_MMA(1, 1, At, B1); PG8_BAR; PG8_SCHED;
            PG8_LDB(B0, 1, 0); PG8_LDB(B1, 1, 1); PG8_LDA(At, 1, 0); PG8_STAGE_A(PG8_SA(0, 1), a2, v2[1]);
            PG8_WAIT_V(8); PG8_WAIT_L(0); PG8_BAR; PG8_SCHED; PG8_MMA(0, 0, At, B0); PG8_MMA(0, 1, At, B1); PG8_BAR; PG8_SCHED;
            PG8_LDA(At, 1, 1); PG8_STAGE_B(PG8_SB(1, 0), bb + ko3); PG8_STAGE_B(PG8_SB(1, 1), bb + ko3 + hstep); PG8_STAGE_A(PG8_SA(1, 0), a3, v2[0]);
            PG8_WAIT_V(8); PG8_WAIT_L(0); PG8_BAR; PG8_SCHED; PG8_MMA(1, 0, At, B0); PG8_MMA(1, 1, At, B1); PG8_BAR; PG8_SCHED;
        }
        E(acc, cur, wr, wc, fr, fq);
        if (!has_next) break;
#pragma unroll
        for (int a = 0; a < 2; ++a)
#pragma unroll
            for (int b = 0; b < 2; ++b)
#pragma unroll
                for (int m = 0; m < 4; ++m)
#pragma unroll
                    for (int n = 0; n < 2; ++n) acc[a][b][m][n] = (acc_t){0, 0, 0, 0};
        cur = nxt; cB = nB; rc = rn; ++ui;
#pragma unroll
        for (int h = 0; h < 2; ++h)
#pragma unroll
            for (int i = 0; i < 2; ++i) vc[h][i] = vn[h][i];
    }
    PG8_WAIT_V(0);
    if (wr == 0) PG8_BAR;
    PG8_BAR;
#undef PG8_SA
#undef PG8_SB
#undef PG8_STAGE_A
#undef PG8_STAGE_B
#undef PG8_LDA
#undef PG8_LDB
#undef PG8_MMA
#undef PG8_WAIT_V
#undef PG8_WAIT_L
#undef PG8_BAR
#undef PG8_SCHED
}

#define EPI_LOOP_BEGIN \
    _Pragma("unroll") for (int ai = 0; ai < 2; ++ai) _Pragma("unroll") for (int m = 0; m < 4; ++m) { const int row = u.pm * BM + ai * HALF + wr * 64 + m * 16 + fr; \
    _Pragma("unroll") for (int bj = 0; bj < 2; ++bj) { const int col = u.pn * BM + bj * HALF + wc * 32 + 8 * fq; f32x4 v0 = acc[ai][bj][m][0], v1 = acc[ai][bj][m][1];
#define EPI_LOOP_END } }
__device__ __forceinline__ u32x4 pack8(f32x4 v0, f32x4 v1) { u32x4 w; w.x = pk2(v0[0], v0[1]); w.y = pk2(v0[2], v0[3]); w.z = pk2(v1[0], v1[1]); w.w = pk2(v1[2], v1[3]); return w; }

template <int MODE> struct EpiProj {
    bf16_t* O; int ldc; const float* rope; const float* rs0; const float* sw;
    __device__ __forceinline__ void operator()(const i32x4 (&acc)[2][2][4][2], const Unit& u, int wr, int wc, int fr, int fq) const {
        const int row0 = u.pm * BM + wr * 64 + fr, colb = u.pn * BM + wc * 32 + 8 * fq;
        float rsr[8]; f32x4 s0[2], s1[2];
#pragma unroll
        for (int i = 0; i < 8; ++i) rsr[i] = rs0[row0 + (i >> 2) * HALF + (i & 3) * 16];
#pragma unroll
        for (int bj = 0; bj < 2; ++bj) { s0[bj] = *(const f32x4*)(sw + colb + bj * HALF); s1[bj] = *(const f32x4*)(sw + colb + bj * HALF + 4); }
#pragma unroll
        for (int ai = 0; ai < 2; ++ai) {
            f32x4 csv[4][2], snv[4][2];
            if (MODE == 2 && u.pn < 4) {
#pragma unroll
                for (int m = 0; m < 4; ++m)
#pragma unroll
                    for (int bj = 0; bj < 2; ++bj) { const int s = (row0 + ai * HALF + m * 16) & (SEQ - 1), i0 = ((colb + bj * HALF) & 127) >> 1; csv[m][bj] = *(const f32x4*)(rope + s * 64 + i0); snv[m][bj] = *(const f32x4*)(rope + SEQ * 64 + s * 64 + i0); }
            }
#pragma unroll
        for (int m = 0; m < 4; ++m) { const int row = row0 + ai * HALF + m * 16; const float rsv = rsr[ai * 4 + m];
#pragma unroll
        for (int bj = 0; bj < 2; ++bj) { const int col = colb + bj * HALF;
            f32x4 v0, v1;
#pragma unroll
            for (int j = 0; j < 4; ++j) { v0[j] = (float)acc[ai][bj][m][0][j] * (s0[bj][j] * rsv); v1[j] = (float)acc[ai][bj][m][1][j] * (s1[bj][j] * rsv); }
            if (MODE == 2) {
                if (u.pn < 4) {
                    const int head = 2 * (u.pn & 1) + bj;
                    const float lg = __builtin_log2f(1.0f - __builtin_amdgcn_exp2f(-5.0f - (float)head));
                    const float ii = (float)(row & 127);
                    const float fac = __builtin_amdgcn_exp2f((u.pn < 2 ? ii : -ii) * lg);
                    const f32x4 c4 = csv[m][bj], s4 = snv[m][bj];
                    f32x4 r0, r1;
                    r0[0] = (v0[0] * c4[0] - v0[1] * s4[0]) * fac; r0[1] = (v0[0] * s4[0] + v0[1] * c4[0]) * fac;
                    r0[2] = (v0[2] * c4[1] - v0[3] * s4[1]) * fac; r0[3] = (v0[2] * s4[1] + v0[3] * c4[1]) * fac;
                    r1[0] = (v1[0] * c4[2] - v1[1] * s4[2]) * fac; r1[1] = (v1[0] * s4[2] + v1[1] * c4[2]) * fac;
                    r1[2] = (v1[2] * c4[3] - v1[3] * s4[3]) * fac; r1[3] = (v1[2] * s4[3] + v1[3] * c4[3]) * fac;
                    v0 = r0; v1 = r1;
                } else if (u.pn >= 8) {
#pragma unroll
                    for (int j = 0; j < 4; ++j) { v0[j] = v0[j] * sigmoidf_(v0[j]); v1[j] = v1[j] * sigmoidf_(v1[j]); }
                }
            }
            *(u32x4*)(O + (size_t)row * ldc + col) = pack8(v0, v1);
        } } }
    }
};
struct EpiM1 {
    bf16_t* O; const bf16_t* gate;
    __device__ __forceinline__ void operator()(const f32x4 (&acc)[2][2][4][2], const Unit& u, int wr, int wc, int fr, int fq) const {
        const int row0 = u.pm * BM + wr * 64 + fr, colb = u.pn * BM + wc * 32 + 8 * fq;
#pragma unroll
        for (int ai = 0; ai < 2; ++ai) {
            u32x4 gw[4][2];
#pragma unroll
            for (int m = 0; m < 4; ++m)
#pragma unroll
                for (int bj = 0; bj < 2; ++bj) gw[m][bj] = *(const u32x4*)(gate + (size_t)(row0 + ai * HALF + m * 16) * N_GATE + colb + bj * HALF);
#pragma unroll
            for (int m = 0; m < 4; ++m)
#pragma unroll
                for (int bj = 0; bj < 2; ++bj) { const u32x4 g = gw[m][bj]; f32x4 v0 = acc[ai][bj][m][0], v1 = acc[ai][bj][m][1];
                    v0[0] *= sigmoidf_(bflo(g.x)); v0[1] *= sigmoidf_(bfhi(g.x)); v0[2] *= sigmoidf_(bflo(g.y)); v0[3] *= sigmoidf_(bfhi(g.y));
                    v1[0] *= sigmoidf_(bflo(g.z)); v1[1] *= sigmoidf_(bfhi(g.z)); v1[2] *= sigmoidf_(bflo(g.w)); v1[3] *= sigmoidf_(bfhi(g.w));
                    *(u32x4*)(O + (size_t)(row0 + ai * HALF + m * 16) * DM + colb + bj * HALF) = pack8(v0, v1); }
        }
    }
};
struct EpiMerge {
    bf16_t* O; const bf16_t* gate; const bf16_t* M1;
    __device__ __forceinline__ void operator()(const f32x4 (&acc)[2][2][4][2], const Unit& u, int wr, int wc, int fr, int fq) const {
        const int row0 = u.pm * BM + wr * 64 + fr, colb = u.pn * BM + wc * 32 + 8 * fq;
#pragma unroll
        for (int ai = 0; ai < 2; ++ai)
#pragma unroll
        for (int mh = 0; mh < 2; ++mh) {
            u32x4 gw[2][2], mw[2][2];
#pragma unroll
            for (int m2 = 0; m2 < 2; ++m2)
#pragma unroll
                for (int bj = 0; bj < 2; ++bj) { const size_t r = (size_t)(row0 + ai * HALF + (mh * 2 + m2) * 16); gw[m2][bj] = *(const u32x4*)(gate + r * N_GATE + 1024 + colb + bj * HALF); mw[m2][bj] = *(const u32x4*)(M1 + r * DM + colb + bj * HALF); }
#pragma unroll
            for (int m2 = 0; m2 < 2; ++m2)
#pragma unroll
                for (int bj = 0; bj < 2; ++bj) { const int m = mh * 2 + m2; const u32x4 g = gw[m2][bj], q = mw[m2][bj]; f32x4 v0 = acc[ai][bj][m][0], v1 = acc[ai][bj][m][1];
                    v0[0] = v0[0] * sigmoidf_(bflo(g.x)) + bflo(q.x); v0[1] = v0[1] * sigmoidf_(bfhi(g.x)) + bfhi(q.x); v0[2] = v0[2] * sigmoidf_(bflo(g.y)) + bflo(q.y); v0[3] = v0[3] * sigmoidf_(bfhi(g.y)) + bfhi(q.y);
                    v1[0] = v1[0] * sigmoidf_(bflo(g.z)) + bflo(q.z); v1[1] = v1[1] * sigmoidf_(bfhi(g.z)) + bfhi(q.z); v1[2] = v1[2] * sigmoidf_(bflo(g.w)) + bflo(q.w); v1[3] = v1[3] * sigmoidf_(bfhi(g.w)) + bfhi(q.w);
                    *(u32x4*)(O + (size_t)(row0 + ai * HALF + m * 16) * DM + colb + bj * HALF) = pack8(v0, v1); }
        }
    }
};
struct EpiX1 {
    const float* x; float* x1;
    __device__ __forceinline__ void operator()(const f32x4 (&acc)[2][2][4][2], const Unit& u, int wr, int wc, int fr, int fq) const {
        const int row0 = u.pm * BM + wr * 64 + fr, colb = u.pn * BM + wc * 32 + 8 * fq;
#pragma unroll
        for (int ai = 0; ai < 2; ++ai)
#pragma unroll
        for (int mh = 0; mh < 2; ++mh) {
            f32x4 xv[2][2][2];
#pragma unroll
            for (int m2 = 0; m2 < 2; ++m2)
#pragma unroll
                for (int bj = 0; bj < 2; ++bj) { const size_t o = (size_t)(row0 + ai * HALF + (mh * 2 + m2) * 16) * DM + colb + bj * HALF; xv[m2][bj][0] = *(const f32x4*)(x + o); xv[m2][bj][1] = *(const f32x4*)(x + o + 4); }
#pragma unroll
            for (int m2 = 0; m2 < 2; ++m2)
#pragma unroll
                for (int bj = 0; bj < 2; ++bj) { const int m = mh * 2 + m2; const size_t o = (size_t)(row0 + ai * HALF + m * 16) * DM + colb + bj * HALF;
                    *(f32x4*)(x1 + o) = acc[ai][bj][m][0] + xv[m2][bj][0]; *(f32x4*)(x1 + o + 4) = acc[ai][bj][m][1] + xv[m2][bj][1]; }
        }
    }
};
struct EpiSwiglu {
    bf16_t* act; const float* b1; const float* rs; const float* sw;
    __device__ __forceinline__ void operator()(const i32x4 (&acc)[2][2][4][2], const Unit& u, int wr, int wc, int fr, int fq) const {
        const int c0 = u.pn * 128 + wc * 32 + 8 * fq;
        const float* bg = b1 + (size_t)u.e * 2048 + c0; const float* bu = bg + 1024;
        const f32x4 bg0 = *(const f32x4*)bg, bg1 = *(const f32x4*)(bg + 4), bu0 = *(const f32x4*)bu, bu1 = *(const f32x4*)(bu + 4);
        const float* sg = sw + (size_t)u.e * 2048 + u.pn * 256 + wc * 32 + 8 * fq; const float* su = sg + 128;
        const f32x4 sg0 = *(const f32x4*)sg, sg1 = *(const f32x4*)(sg + 4), su0 = *(const f32x4*)su, su1 = *(const f32x4*)(su + 4);
        float rsr[8];
#pragma unroll
        for (int i = 0; i < 8; ++i) rsr[i] = rs[u.pm * BM + (i >> 2) * HALF + wr * 64 + (i & 3) * 16 + fr];
#pragma unroll
        for (int ai = 0; ai < 2; ++ai)
#pragma unroll
            for (int m = 0; m < 4; ++m) {
                const int row = u.pm * BM + ai * HALF + wr * 64 + m * 16 + fr;
                const float r = rsr[ai * 4 + m];
                f32x4 a0, a1;
#pragma unroll
                for (int j = 0; j < 4; ++j) {
                    float g = fminf((float)acc[ai][0][m][0][j] * (r * sg0[j]) + bg0[j], 7.0f), up = fminf(fmaxf((float)acc[ai][1][m][0][j] * (r * su0[j]) + bu0[j], -7.0f), 7.0f);
                    a0[j] = (up + 1.0f) * g * sigmoidf_(1.702f * g);
                    g = fminf((float)acc[ai][0][m][1][j] * (r * sg1[j]) + bg1[j], 7.0f); up = fminf(fmaxf((float)acc[ai][1][m][1][j] * (r * su1[j]) + bu1[j], -7.0f), 7.0f);
                    a1[j] = (up + 1.0f) * g * sigmoidf_(1.702f * g);
                }
                const float qs = 1.0f / ACT_STEP;
                int q[8];
#pragma unroll
                for (int j = 0; j < 4; ++j) { q[j] = __float2int_rn(fminf(fmaxf(a0[j] * qs, -127.0f), 127.0f)); q[4 + j] = __float2int_rn(fminf(fmaxf(a1[j] * qs, -127.0f), 127.0f)); }
                u32x2 ow; ow.x = (unsigned)(q[0] & 255) | ((unsigned)(q[1] & 255) << 8) | ((unsigned)(q[2] & 255) << 16) | ((unsigned)q[3] << 24);
                ow.y = (unsigned)(q[4] & 255) | ((unsigned)(q[5] & 255) << 8) | ((unsigned)(q[6] & 255) << 16) | ((unsigned)q[7] << 24);
                *(u32x2*)((signed char*)act + (size_t)row * DEXP + c0) = ow;
            }
    }
};
struct EpiDown {
    bf16_t* Y; const float* b2; const float* w; const float* sw;
    __device__ __forceinline__ void operator()(const i32x4 (&acc)[2][2][4][2], const Unit& u, int wr, int wc, int fr, int fq) const {
        const int row0 = u.pm * BM + wr * 64 + fr, colb = u.pn * BM + wc * 32 + 8 * fq;
        float wt[8]; f32x4 s0[2], s1[2], b0[2], b1v[2];
#pragma unroll
        for (int i = 0; i < 8; ++i) wt[i] = w[row0 + (i >> 2) * HALF + (i & 3) * 16];
#pragma unroll
        for (int bj = 0; bj < 2; ++bj) { const float* bb = b2 + (size_t)u.e * DM + colb + bj * HALF; const float* sp = sw + (size_t)u.e * DM + colb + bj * HALF;
            s0[bj] = *(const f32x4*)sp * ACT_STEP; s1[bj] = *(const f32x4*)(sp + 4) * ACT_STEP; b0[bj] = *(const f32x4*)bb; b1v[bj] = *(const f32x4*)(bb + 4); }
#pragma unroll
        for (int ai = 0; ai < 2; ++ai)
#pragma unroll
        for (int m = 0; m < 4; ++m) { const int row = row0 + ai * HALF + m * 16; const float wv = wt[ai * 4 + m];
#pragma unroll
        for (int bj = 0; bj < 2; ++bj) { const int col = colb + bj * HALF;
            f32x4 v0, v1;
#pragma unroll
            for (int j = 0; j < 4; ++j) { v0[j] = ((float)acc[ai][bj][m][0][j] * s0[bj][j] + b0[bj][j]) * wv; v1[j] = ((float)acc[ai][bj][m][1][j] * s1[bj][j] + b1v[bj][j]) * wv; }
            *(u32x4*)(Y + (size_t)row * DM + col) = pack8(v0, v1);
        } }
    }
};
}

__device__ const unsigned char T5B[3][129] = {
{0,1,2,3,4,5,6,7,8,9,10,11,12,13,14,15,16,16,16,16,16,16,17,17,17,17,17,17,17,17,18,18,18,18,18,18,18,18,18,18,19,19,19,19,19,19,19,19,19,19,19,19,19,19,20,20,20,20,20,20,20,20,20,20,20,20,20,20,20,20,20,20,20,21,21,21,21,21,21,21,21,21,21,21,21,21,21,21,21,21,21,21,21,21,21,21,21,21,21,22,22,22,22,22,22,22,22,22,22,22,22,22,22,22,22,22,22,22,22,22,22,22,22,22,22,22,22,22,22},
{0,4,8,12,16,16,17,17,18,18,19,19,19,19,20,20,20,20,20,21,21,21,21,21,21,22,22,22,22,22,22,22,22,22,23,23,23,23,23,23,23,23,23,23,23,23,24,24,24,24,24,24,24,24,24,24,24,24,24,24,24,24,25,25,25,25,25,25,25,25,25,25,25,25,25,25,25,25,25,25,25,25,25,26,26,26,26,26,26,26,26,26,26,26,26,26,26,26,26,26,26,26,26,26,26,26,26,26,26,26,26,26,26,27,27,27,27,27,27,27,27,27,27,27,27,27,27,27,27},
{0,16,18,19,20,21,21,22,22,23,23,23,24,24,24,24,25,25,25,25,25,26,26,26,26,26,26,26,26,27,27,27,27,27,27,27,27,27,27,28,28,28,28,28,28,28,28,28,28,28,28,28,29,29,29,29,29,29,29,29,29,29,29,29,29,29,29,29,29,29,30,30,30,30,30,30,30,30,30,30,30,30,30,30,30,30,30,30,30,30,30,30,30,30,30,31,31,31,31,31,31,31,31,31,31,31,31,31,31,31,31,31,31,31,31,31,31,31,31,31,31,31,31,31,31,31,31,31,31}};

struct Frame {
    LAS unsigned char* lds;
    int tid, lane, wave, G;
    unsigned char* ws; unsigned char* dout;
    const float* in[15];
};
struct Args { const float* in[15]; float* out; unsigned char* ws; int ph_lo, ph_hi;
 };

template <int CS_MODE  , int NMAP  >
__device__ __forceinline__ void p0_transpose_item(const float* W, int K, int N, int ld, bf16_t* WT, const float* rs, LAS float* scr, int item, int lane) {
    const int nblk = N / 64, kb = item / nblk, nb = item % nblk, k0 = 64 * kb, n0 = 64 * nb;
    const int lr = lane >> 4, lc = (lane & 15) * 4;
    f32x4 v[16];
#pragma unroll
    for (int i = 0; i < 16; ++i) v[i] = *(const f32x4*)(W + (size_t)(k0 + 4 * i + lr) * ld + n0 + lc);
#pragma unroll
    for (int i = 0; i < 16; ++i) {
        const int kk = 4 * i + lr; const float r = rs ? rs[k0 + kk] : 1.0f;
        scr[kk * 65 + lc + 0] = v[i][0] * r; scr[kk * 65 + lc + 1] = v[i][1] * r; scr[kk * 65 + lc + 2] = v[i][2] * r; scr[kk * 65 + lc + 3] = v[i][3] * r;
    }
    LDS_WAIT(); asm volatile("" ::: "memory");
    const int c = lane & 7;
#pragma unroll
    for (int j = 0; j < 8; ++j) {
        const int nl = (lane >> 3) + 8 * j, n = n0 + nl; const LAS float* sp = scr + (8 * c) * 65 + nl;
        float cs = 1.0f;
        if (CS_MODE == 2) { if (n >= 512 && n < 1024) cs = 0.08838834764831845f; }
        int nm = n;
        if (NMAP == 1) { nm = (n < 1024) ? (256 * (n >> 7) + (n & 127)) : (256 * ((n - 1024) >> 7) + 128 + ((n - 1024) & 127)); }
        u32x4 o; o.x = pk2(sp[0 * 65] * cs, sp[1 * 65] * cs); o.y = pk2(sp[2 * 65] * cs, sp[3 * 65] * cs); o.z = pk2(sp[4 * 65] * cs, sp[5 * 65] * cs); o.w = pk2(sp[6 * 65] * cs, sp[7 * 65] * cs);
        *(u32x4*)(WT + (size_t)nm * K + k0 + 8 * c) = o;
    }
    LDS_WAIT(); asm volatile("" ::: "memory");
}
struct QItem { int map, ld, n0; const float* W; const float* rs; signed char* Q; float* SW; };
#define P0_NMAP(MAP, n) ((MAP) == 1 ? (((n) < 1024) ? (256 * ((n) >> 7) + ((n) & 127)) : (256 * (((n) - 1024) >> 7) + 128 + (((n) - 1024) & 127))) : (n))
__device__ __forceinline__ void p0q_load(const Frame& F, const QItem& q, f32x4 (&v)[32], float (&rsv)[32]) {
    const int lr = F.lane >> 4, lc4 = F.lane & 15, w = F.wave;
    const unsigned voff = (unsigned)(((128 * w + 4 * lr) * q.ld + q.n0 + 4 * lc4) * 4);
    const float* rsl = q.rs + 128 * w + 4 * lr;
#pragma unroll
    for (int i = 0; i < 32; ++i) { const int kk = 16 * (i >> 2) + (i & 3); v[i] = *(const f32x4*)((const char*)q.W + (size_t)kk * q.ld * 4 + voff); rsv[i] = rsl[kk]; }
}
__device__ __forceinline__ void p0_quant_all(Frame& F, const float* w1, const float* w2, const float* w_in, const float* g_ffn, const float* g_mix) {
    LAS float* cm = (LAS float*)(F.lds + 8 * 16896);
    LAS unsigned* Tl = (LAS unsigned*)(F.lds + F.wave * 16896);
    const int lr = F.lane >> 4, lc4 = F.lane & 15, w = F.wave;
    constexpr int NIT = NEXP * 32 + 152 + NEXP * 16;
    auto item = [&](int it) { QItem q;
        if (it < NEXP * 32) { const int e = it >> 5; q.map = 1; q.W = w1 + (size_t)e * 1024 * 2048; q.ld = 2048; q.n0 = (it & 31) * 64; q.rs = g_ffn; q.Q = (signed char*)(F.ws + WS_W1) + (size_t)e * 2048 * 1024; q.SW = (float*)(F.ws + WS_SW1) + e * 2048; }
        else if (it < NEXP * 32 + 152) { q.map = 2; q.W = w_in; q.ld = PROJ_W; q.n0 = (it - NEXP * 32) * 64; q.rs = g_mix; q.Q = (signed char*)(F.ws + WS_WINQ); q.SW = (float*)(F.ws + WS_SWIN); }
        else { const int r2 = it - NEXP * 32 - 152, e = r2 >> 4; q.map = 0; q.W = w2 + (size_t)e * 1024 * 1024; q.ld = 1024; q.n0 = (r2 & 15) * 64; q.rs = nullptr; q.Q = (signed char*)(F.ws + WS_W2) + (size_t)e * 1024 * 1024; q.SW = (float*)(F.ws + WS_SW2) + e * 1024; }
        return q; };
    f32x4 v[32]; float rsv[32];
    int it = blockIdx.x;
    QItem q = item(it < NIT ? it : 0);
    if (q.rs == nullptr) q.rs = g_mix;
    if (it < NIT) p0q_load(F, q, v, rsv);
    while (it < NIT) {
        const int itn = it + F.G; const bool has = itn < NIT;
        QItem qn = item(has ? itn : it); if (qn.rs == nullptr) qn.rs = g_mix;
        const int MAP = q.map;
        f32x4 mx = {0.f, 0.f, 0.f, 0.f};
#pragma unroll
        for (int i = 0; i < 32; ++i) { if (MAP != 0) v[i] *= rsv[i]; mx[0] = fmaxf(mx[0], fabsf(v[i][0])); mx[1] = fmaxf(mx[1], fabsf(v[i][1])); mx[2] = fmaxf(mx[2], fabsf(v[i][2])); mx[3] = fmaxf(mx[3], fabsf(v[i][3])); }
#pragma unroll
        for (int c = 0; c < 4; ++c) { mx[c] = fmaxf(mx[c], __shfl_xor(mx[c], 16)); mx[c] = fmaxf(mx[c], __shfl_xor(mx[c], 32)); }
        __syncthreads();
        if (lr == 0) *(LAS f32x4*)(cm + w * 64 + 4 * lc4) = mx;
        __syncthreads();
#pragma unroll
        for (int ww = 0; ww < 8; ++ww) { const f32x4 o = *(const LAS f32x4*)(cm + ww * 64 + 4 * lc4); mx[0] = fmaxf(mx[0], o[0]); mx[1] = fmaxf(mx[1], o[1]); mx[2] = fmaxf(mx[2], o[2]); mx[3] = fmaxf(mx[3], o[3]); }
        f32x4 inv;
#pragma unroll
        for (int c = 0; c < 4; ++c) inv[c] = mx[c] > 0.f ? 127.0f / mx[c] : 0.f;
        if (w == 0 && lr == 0) {
#pragma unroll
            for (int c = 0; c < 4; ++c) { const int n = q.n0 + 4 * lc4 + c; float st = mx[c] * (1.0f / 127.0f); if (MAP == 2 && n < 1536) st *= 0.08838834764831845f * LOG2E; if (MAP == 2 && n >= 5120 && n < 5632) st *= 0.08838834764831845f; q.SW[P0_NMAP(MAP, n)] = st; }
        }
#pragma unroll
        for (int j = 0; j < 8; ++j)
#pragma unroll
            for (int c = 0; c < 4; ++c) {
                const int q0 = __float2int_rn(v[4 * j + 0][c] * inv[c]), q1 = __float2int_rn(v[4 * j + 1][c] * inv[c]), q2 = __float2int_rn(v[4 * j + 2][c] * inv[c]), q3 = __float2int_rn(v[4 * j + 3][c] * inv[c]);
                Tl[(4 * lc4 + c) * 33 + 4 * j + lr] = (unsigned)(q0 & 255) | ((unsigned)(q1 & 255) << 8) | ((unsigned)(q2 & 255) << 16) | ((unsigned)q3 << 24);
            }
        if (has) p0q_load(F, qn, v, rsv);
        LDS_WAIT(); asm volatile("" ::: "memory");
#pragma unroll
        for (int jj = 0; jj < 8; ++jj) {
            const int nl = (F.lane >> 3) + 8 * jj, ch = F.lane & 7, n = q.n0 + nl;
            u32x4 o; o.x = Tl[nl * 33 + 4 * ch + 0]; o.y = Tl[nl * 33 + 4 * ch + 1]; o.z = Tl[nl * 33 + 4 * ch + 2]; o.w = Tl[nl * 33 + 4 * ch + 3];
            *(u32x4*)(q.Q + (size_t)P0_NMAP(MAP, n) * 1024 + 128 * w + 16 * ch) = o;
        }
        LDS_WAIT(); asm volatile("" ::: "memory");
        q = qn; it = itn;
    }
    __syncthreads();
}
#undef P0_NMAP
__device__ __forceinline__ void p0_prologue(Frame& F) {
    LAS float* scr = (LAS float*)(F.lds + F.wave * 16896);
    const int gw = blockIdx.x * 8 + F.wave, NGW = F.G * 8;
    const float* x = F.in[0]; const float* g_mix = F.in[1]; const float* w_in = F.in[2]; const float* rel_bias = F.in[3];
    const float* w_att = F.in[4]; const float* w_ret = F.in[5]; const float* w_out = F.in[6]; const float* g_ffn = F.in[7];
    const float* w_router = F.in[8]; const float* w1 = F.in[10]; const float* w2 = F.in[12];
    constexpr int I_IN = 0, I_ATT = 8 * 16, I_RET = 16 * 16, I_OUT = 16 * 16, I_W1 = 16 * 32, I_W2 = 16 * 16;
    constexpr int NITEMS = I_IN + I_ATT + I_RET + I_OUT;
    for (int it = gw; it < NITEMS; it += NGW) {
        int r = it;
        if (r < I_ATT) { p0_transpose_item<0, 0>(w_att, 512, 1024, 1024, (bf16_t*)(F.ws + WS_WATT), nullptr, scr, r, F.lane); continue; } r -= I_ATT;
        if (r < I_RET) { p0_transpose_item<0, 0>(w_ret, 1024, 1024, 1024, (bf16_t*)(F.ws + WS_WRET), nullptr, scr, r, F.lane); continue; } r -= I_RET;
        p0_transpose_item<0, 0>(w_out, 1024, 1024, 1024, (bf16_t*)(F.ws + WS_WOUT), nullptr, scr, r, F.lane);
    }
    p0_quant_all(F, w1, w2, w_in, g_ffn, g_mix);
    unsigned* HBQ = (unsigned*)(F.dout + DO_HBQ); float* RS0 = (float*)(F.ws + WS_RS0);
    for (int m = 2 * gw; m < T_TOK; m += 2 * NGW) {
        const f32x4* xr = (const f32x4*)(x + (size_t)m * DM) + F.lane;
        f32x4 v[8]; float s0 = 0.f, s1 = 0.f;
#pragma unroll
        for (int j = 0; j < 8; ++j) v[j] = xr[64 * j];
#pragma unroll
        for (int j = 0; j < 4; ++j) { s0 += (v[j][0] * v[j][0] + v[j][1] * v[j][1]) + (v[j][2] * v[j][2] + v[j][3] * v[j][3]); s1 += (v[j + 4][0] * v[j + 4][0] + v[j + 4][1] * v[j + 4][1]) + (v[j + 4][2] * v[j + 4][2] + v[j + 4][3] * v[j + 4][3]); }
        const float r0 = 1.0f / sqrtf(wave_sum(s0) * (1.0f / DM) + NORM_EPS), r1 = 1.0f / sqrtf(wave_sum(s1) * (1.0f / DM) + NORM_EPS);
        float a0 = 0.f, a1 = 0.f;
#pragma unroll
        for (int j = 0; j < 4; ++j) { a0 = fmaxf(fmaxf(a0, fmaxf(fabsf(v[j][0]), fabsf(v[j][1]))), fmaxf(fabsf(v[j][2]), fabsf(v[j][3]))); a1 = fmaxf(fmaxf(a1, fmaxf(fabsf(v[j + 4][0]), fabsf(v[j + 4][1]))), fmaxf(fabsf(v[j + 4][2]), fabsf(v[j + 4][3]))); }
#pragma unroll
        for (int o = 1; o < 64; o <<= 1) { a0 = fmaxf(a0, __shfl_xor(a0, o)); a1 = fmaxf(a1, __shfl_xor(a1, o)); }
        const float q0i = a0 > 0.f ? 127.0f / a0 : 0.f, q1i = a1 > 0.f ? 127.0f / a1 : 0.f;
        if (F.lane == 0) { RS0[m] = r0 * a0 * (1.0f / 127.0f); RS0[m + 1] = r1 * a1 * (1.0f / 127.0f); }
        unsigned* oq = HBQ + (size_t)m * 256 + F.lane;
#pragma unroll
        for (int j = 0; j < 8; ++j) { const float qi = j < 4 ? q0i : q1i; const int b0 = __float2int_rn(v[j][0] * qi), b1 = __float2int_rn(v[j][1] * qi), b2 = __float2int_rn(v[j][2] * qi), b3 = __float2int_rn(v[j][3] * qi);
            oq[64 * j] = (unsigned)(b0 & 255) | ((unsigned)(b1 & 255) << 8) | ((unsigned)(b2 & 255) << 16) | ((unsigned)b3 << 24); }
    }
    const int gt = blockIdx.x * 512 + F.tid, NGT = F.G * 512;
    float* rope = (float*)(F.ws + WS_ROPE);
    for (int i = gt; i < SEQ * 64; i += NGT) {
        const int s = i >> 6, p = i & 63;
        const float inv = powf(10000.0f, -(float)(2 * p) / 128.0f);
        const float ang = (float)s * inv;
        float sn, cs; sincosf(ang, &sn, &cs);
        rope[i] = cs; rope[SEQ * 64 + i] = sn;
    }
    float* biasT = (float*)(F.ws + WS_BIAS);
    for (int i = gt; i < 12 * 132; i += NGT) {
        const int gh = i / 132, j = i % 132, g = gh >> 2;
        biasT[i] = (j <= 128) ? rel_bias[(int)T5B[g][j] * 12 + gh] * LOG2E : 0.0f;
    }
    float* wrl = (float*)(F.ws + WS_WRL);
    for (int i = gt; i < 1024 * 32; i += NGT) {
        const int c = i & 3, e = (i >> 2) & 31, g = (i >> 7) & 3, ii = i >> 9, k = 16 * ii + 4 * g + c;
        wrl[i] = g_ffn[k] * w_router[k * 32 + e];
    }
}

__device__ __forceinline__ void attn_phase(Frame& F, int g) {
    const int lg = (g == 0) ? 0 : (g == 1 ? 2 : 4), d = 1 << lg, nblk = (SEQ >> lg) >> 7;
    const bf16_t* AB = (const bf16_t*)(F.ws + DY_ATTBUF);
    bf16_t* ATT = (bf16_t*)(F.ws + DY_ATT);
    float* LSE = (float*)(F.ws + WS_LSE);
    const float* biasT = (const float*)(F.ws + WS_BIAS);
    LAS unsigned char* Kl = F.lds; LAS unsigned char* Vl = F.lds + 65536;
    LAS float* biasL = (LAS float*)(F.lds + LDS_AUX);
    const int lane = F.lane, w = F.wave, g4 = lane >> 4, l15 = lane & 15, q4 = l15 >> 2, p4 = lane & 3;
    u32x4 kreg[8], vreg[8]; bf16x8 qnx[4];
#define ATT_DECODE(it_, blk_, r_, slot_, b_) const int blk_ = (it_) % nblk, r_ = ((it_) / nblk) % d, slot_ = ((it_) / (nblk * d)) & 3, b_ = (it_) / (nblk * d * 4)
#define ATT_PREFETCH(it_) do { ATT_DECODE(it_, pblk, pr, pslot, pb); const int pm0 = pblk * 128, phead = 4 * g + pslot; \
        _Pragma("unroll") for (int j = 0; j < 8; ++j) { const int cidx = F.tid + 512 * j, kr = cidx >> 4, ch = cidx & 15; int step = pm0 - 128 + kr; step = step < 0 ? 0 : step; \
            const size_t rowoff = ((size_t)pb * SEQ + (size_t)step * d + pr) * N_ATT + phead * 128 + ch * 8; kreg[j] = *(const u32x4*)(AB + rowoff + 1536); vreg[j] = *(const u32x4*)(AB + rowoff + 3072); } \
        const size_t pq = (size_t)pb * SEQ + (size_t)(pm0 + 16 * w + l15) * d + pr; \
        _Pragma("unroll") for (int s = 0; s < 4; ++s) qnx[s] = *(const bf16x8*)(AB + pq * N_ATT + phead * 128 + 32 * s + 8 * g4); } while (0)
    if ((int)blockIdx.x < 2048) ATT_PREFETCH((int)blockIdx.x);
    for (int item = blockIdx.x; item < 2048; item += F.G) {
        ATT_DECODE(item, blk, r, slot, b);
        const int m0 = blk * 128, head = 4 * g + slot;
        __syncthreads();
        if (F.tid < 132) biasL[F.tid] = biasT[head * 132 + F.tid];
#pragma unroll
        for (int j = 0; j < 8; ++j) { const int cidx = F.tid + 512 * j, kr = cidx >> 4, ch = cidx & 15; *(LAS u32x4*)(Kl + off_b(kr, ch)) = kreg[j]; *(LAS u32x4*)(Vl + off_b(kr, ch)) = vreg[j]; }
        const int qstep = m0 + 16 * w + l15;
        const size_t qrow = (size_t)b * SEQ + (size_t)qstep * d + r;
        bf16x8 qf[4];
#pragma unroll
        for (int s = 0; s < 4; ++s) qf[s] = qnx[s];
        if (item + F.G < 2048) ATT_PREFETCH(item + F.G);
        __syncthreads();
        f32x4 sacc[9];
#pragma unroll
        for (int tt = 0; tt < 9; ++tt) {
            sacc[tt] = (f32x4){0.f, 0.f, 0.f, 0.f};
#pragma unroll
            for (int s = 0; s < 4; ++s) {
                const bf16x8 kf = *(const LAS bf16x8*)(Kl + off_b(16 * (w + tt) + l15, 4 * s + g4));
                sacc[tt] = __builtin_amdgcn_mfma_f32_16x16x32_bf16(kf, qf[s], sacc[tt], 0, 0, 0);
            }
        }
        const int kmin = 128 - m0;
        float mx = -1e30f;
#pragma unroll
        for (int tt = 0; tt < 9; ++tt)
#pragma unroll
            for (int rg = 0; rg < 4; ++rg) {
                const int dist = 128 + l15 - 16 * tt - 4 * g4 - rg, kidx = 16 * (w + tt) + 4 * g4 + rg;
                const bool valid = (dist >= 0) && (dist <= 128) && (kidx >= kmin);
                const int dc = dist < 0 ? 0 : (dist > 128 ? 128 : dist);
                const float v = valid ? sacc[tt][rg] + biasL[dc] : -1e30f;
                sacc[tt][rg] = v; mx = fmaxf(mx, v);
            }
        mx = fmaxf(mx, __shfl_xor(mx, 16)); mx = fmaxf(mx, __shfl_xor(mx, 32));
        float lsum = 0.f;
#pragma unroll
        for (int tt = 0; tt < 9; ++tt)
#pragma unroll
            for (int rg = 0; rg < 4; ++rg) { const float p = (sacc[tt][rg] > -1e29f) ? fast_exp2(sacc[tt][rg] - mx) : 0.f; sacc[tt][rg] = p; lsum += p; }
        lsum += __shfl_xor(lsum, 16); lsum += __shfl_xor(lsum, 32);
        f32x4 oacc[8];
#pragma unroll
        for (int dt = 0; dt < 8; ++dt) oacc[dt] = (f32x4){0.f, 0.f, 0.f, 0.f};
#pragma unroll
        for (int uu = 0; uu < 5; ++uu) {
            u32x4 pw; pw.x = pk2(sacc[2 * uu][0], sacc[2 * uu][1]); pw.y = pk2(sacc[2 * uu][2], sacc[2 * uu][3]);
            if (uu < 4) { pw.z = pk2(sacc[2 * uu + 1][0], sacc[2 * uu + 1][1]); pw.w = pk2(sacc[2 * uu + 1][2], sacc[2 * uu + 1][3]); } else { pw.z = 0u; pw.w = 0u; }
            const bf16x8 pf = __builtin_bit_cast(bf16x8, pw);
            const int r0 = 16 * (w + 2 * uu) + 4 * g4 + q4, r1 = (uu < 4) ? r0 + 16 : r0;
#pragma unroll
            for (int dt = 0; dt < 8; ++dt) {
                const s16x4 lo = tr_read(Vl + off_b(r0, 2 * dt + (p4 >> 1)) + 8 * (p4 & 1));
                const s16x4 hi = tr_read(Vl + off_b(r1, 2 * dt + (p4 >> 1)) + 8 * (p4 & 1));
                oacc[dt] = __builtin_amdgcn_mfma_f32_16x16x32_bf16(cat8(lo, hi), pf, oacc[dt], 0, 0, 0);
            }
        }
        const float rl = 1.0f / lsum;
        float lse = mx + __builtin_log2f(lsum);
        float wn = 1.0f, wp = 0.0f;
        bf16_t* orow = ATT + qrow * 512 + slot * 128 + 4 * g4;
        if (g > 0) {
            const float lp = LSE[qrow * 4 + slot];
            const float M = fmaxf(lp, lse); const float en = fast_exp2(lse - M), ep = fast_exp2(lp - M), tot = en + ep;
            wn = en / tot; wp = ep / tot; lse = M + __builtin_log2f(tot);
        }
        u32x2 pvv[8];
        if (g > 0) {
#pragma unroll
            for (int dt = 0; dt < 8; ++dt) pvv[dt] = *(const u32x2*)(orow + 16 * dt);
        }
#pragma unroll
        for (int dt = 0; dt < 8; ++dt) {
            f32x4 o = oacc[dt] * (rl * wn);
            if (g > 0) { const u32x2 pv = pvv[dt]; o[0] += wp * bflo(pv.x); o[1] += wp * bfhi(pv.x); o[2] += wp * bflo(pv.y); o[3] += wp * bfhi(pv.y); }
            u32x2 ow; ow.x = pk2(o[0], o[1]); ow.y = pk2(o[2], o[3]);
            *(u32x2*)(orow + 16 * dt) = ow;
        }
        if (g4 == 0) LSE[qrow * 4 + slot] = lse;
    }
#undef ATT_DECODE
#undef ATT_PREFETCH
}

__device__ __forceinline__ float ret_log2g(int h) { return __builtin_log2f(1.0f - __builtin_amdgcn_exp2f(-5.0f - (float)h)); }
__device__ __forceinline__ void ret_state_phase(Frame& F) {
    const bf16_t* RB = (const bf16_t*)(F.ws + DY_RETBUF);
    bf16_t* SR = (bf16_t*)(F.dout + DO_SR);
    const int lane = F.lane, w = F.wave, g4 = lane >> 4, l15 = lane & 15, q4 = l15 >> 2, p4 = lane & 3;
    for (int item = blockIdx.x; item < 256; item += F.G) {
        const int es = item & 3, h = (item >> 2) & 3, b = item >> 4;
        const float g128 = __builtin_amdgcn_exp2f(128.0f * ret_log2g(h));
        f32x4 acc[4];
#pragma unroll
        for (int et = 0; et < 4; ++et) acc[et] = (f32x4){0.f, 0.f, 0.f, 0.f};
        u32x4 kreg[4], vreg[2];
        const size_t rowbase = (size_t)b * SEQ;
#define RS_LOAD(n) do { \
            _Pragma("unroll") for (int j = 0; j < 4; ++j) { const int cidx = F.tid + 512 * j, jr = cidx >> 4, ch = cidx & 15; kreg[j] = *(const u32x4*)(RB + (rowbase + (n) * 128 + jr) * N_RET + 512 + h * 128 + ch * 8); } \
            _Pragma("unroll") for (int j = 0; j < 2; ++j) { const int cidx = F.tid + 512 * j, jr = cidx >> 3, ch = cidx & 7; vreg[j] = *(const u32x4*)(RB + (rowbase + (n) * 128 + jr) * N_RET + 1024 + h * 256 + es * 64 + ch * 8); } } while (0)
#define RS_STORE(buf) do { \
            _Pragma("unroll") for (int j = 0; j < 4; ++j) { const int cidx = F.tid + 512 * j, jr = cidx >> 4, ch = cidx & 15; *(LAS u32x4*)(F.lds + (buf) * 65536 + off_b(jr, ch)) = kreg[j]; } \
            _Pragma("unroll") for (int j = 0; j < 2; ++j) { const int cidx = F.tid + 512 * j, jr = cidx >> 3, ch = cidx & 7; *(LAS u32x4*)(F.lds + (buf) * 65536 + 32768 + off_b(jr, ch)) = vreg[j]; } } while (0)
        __syncthreads();
        RS_LOAD(0); RS_STORE(0);
        __syncthreads();
        for (int n = 0; n < 32; ++n) {
            const int buf = n & 1;
            if (n + 1 < 32) RS_LOAD(n + 1);
            bf16_t* srow = SR + ((size_t)((b * 4 + h) * 32 + n) * 256 + es * 64 + l15) * 128 + 16 * w + 4 * g4;
#pragma unroll
            for (int et = 0; et < 4; ++et) { u32x2 ow; ow.x = pk2(acc[et][0], acc[et][1]); ow.y = pk2(acc[et][2], acc[et][3]); *(u32x2*)(srow + (size_t)et * 16 * 128) = ow; }
            const LAS unsigned char* Kb = F.lds + buf * 65536; const LAS unsigned char* Vb = Kb + 32768;
#pragma unroll
            for (int ks = 0; ks < 4; ++ks) {
                const int j0 = 32 * ks + 8 * g4 + q4;
                const s16x4 klo = tr_read(Kb + off_b(j0, 2 * w + (p4 >> 1)) + 8 * (p4 & 1));
                const s16x4 khi = tr_read(Kb + off_b(j0 + 4, 2 * w + (p4 >> 1)) + 8 * (p4 & 1));
                const bf16x8 kf = cat8(klo, khi);
#pragma unroll
                for (int et = 0; et < 4; ++et) {
                    const s16x4 vlo = tr_read(Vb + off_b(j0, 2 * et + (p4 >> 1)) + 8 * (p4 & 1));
                    const s16x4 vhi = tr_read(Vb + off_b(j0 + 4, 2 * et + (p4 >> 1)) + 8 * (p4 & 1));
                    acc[et] = __builtin_amdgcn_mfma_f32_16x16x32_bf16(kf, cat8(vlo, vhi), acc[et], 0, 0, 0);
                }
            }
#pragma unroll
            for (int et = 0; et < 4; ++et) acc[et] *= g128;
            if (n + 1 < 32) RS_STORE(buf ^ 1);
            __syncthreads();
        }
#undef RS_LOAD
#undef RS_STORE
    }
}
__device__ __forceinline__ void ret_out_phase(Frame& F) {
    const bf16_t* RB = (const bf16_t*)(F.ws + DY_RETBUF);
    const bf16_t* SR = (const bf16_t*)(F.dout + DO_SR);
    bf16_t* RETN = (bf16_t*)(F.dout + DO_RETN);
    const int lane = F.lane, w = F.wave, g4 = lane >> 4, l15 = lane & 15, q4 = l15 >> 2, p4 = lane & 3;
    LAS unsigned char* Vl = F.lds;
    LAS unsigned char* Rl = F.lds + 65536;
    for (int item = blockIdx.x; item < 2048; item += F.G) {
        const int n = item & 31, h = (item >> 5) & 3, b = item >> 7;
        const size_t rowbase = (size_t)b * SEQ + n * 128;
        __syncthreads();
#pragma unroll
        for (int j = 0; j < 8; ++j) {
            const int cidx = F.tid + 512 * j;
            { const int jr = cidx >> 5, ch = cidx & 31; const u32x4 v = *(const u32x4*)(RB + (rowbase + jr) * N_RET + 1024 + h * 256 + ch * 8);
              *(LAS u32x4*)(Vl + (ch >> 4) * 32768 + off_b(jr, ch & 15)) = v; }
            { const int er = cidx >> 4, ch = cidx & 15; const u32x4 v = *(const u32x4*)(SR + ((size_t)((b * 4 + h) * 32 + n) * 256 + er) * 128 + ch * 8);
              *(LAS u32x4*)(Rl + off_b(er, ch)) = v; }
        }
        const size_t qrow = rowbase + 16 * w + l15;
        bf16x8 qf[4];
#pragma unroll
        for (int s = 0; s < 4; ++s) qf[s] = *(const bf16x8*)(RB + qrow * N_RET + h * 128 + 32 * s + 8 * g4);
        f32x4 sacc[8];
#pragma unroll
        for (int tt = 0; tt < 8; ++tt) {
            sacc[tt] = (f32x4){0.f, 0.f, 0.f, 0.f};
            if (tt <= w) {
#pragma unroll
                for (int s = 0; s < 4; ++s) {
                    const bf16x8 kf = *(const bf16x8*)(RB + (rowbase + 16 * tt + l15) * N_RET + 512 + h * 128 + 32 * s + 8 * g4);
                    sacc[tt] = __builtin_amdgcn_mfma_f32_16x16x32_bf16(kf, qf[s], sacc[tt], 0, 0, 0);
                }
                if (tt == w) {
#pragma unroll
                    for (int rg = 0; rg < 4; ++rg) if (4 * g4 + rg > l15) sacc[tt][rg] = 0.f;
                }
            }
        }
        __syncthreads();
        f32x4 oacc[16];
#pragma unroll
        for (int et = 0; et < 16; ++et) oacc[et] = (f32x4){0.f, 0.f, 0.f, 0.f};
#pragma unroll
        for (int uu = 0; uu < 4; ++uu) {
            if (2 * uu <= w) {
                u32x4 pw; pw.x = pk2(sacc[2 * uu][0], sacc[2 * uu][1]); pw.y = pk2(sacc[2 * uu][2], sacc[2 * uu][3]);
                pw.z = pk2(sacc[2 * uu + 1][0], sacc[2 * uu + 1][1]); pw.w = pk2(sacc[2 * uu + 1][2], sacc[2 * uu + 1][3]);
                const bf16x8 pf = __builtin_bit_cast(bf16x8, pw);
                const int r0 = 32 * uu + 4 * g4 + q4, r1 = r0 + 16;
#pragma unroll
                for (int et = 0; et < 16; ++et) {
                    const LAS unsigned char* vb = Vl + (et >> 3) * 32768;
                    const s16x4 lo = tr_read(vb + off_b(r0, 2 * (et & 7) + (p4 >> 1)) + 8 * (p4 & 1));
                    const s16x4 hi = tr_read(vb + off_b(r1, 2 * (et & 7) + (p4 >> 1)) + 8 * (p4 & 1));
                    oacc[et] = __builtin_amdgcn_mfma_f32_16x16x32_bf16(cat8(lo, hi), pf, oacc[et], 0, 0, 0);
                }
            }
        }
#pragma unroll
        for (int et = 0; et < 16; ++et)
#pragma unroll
            for (int s = 0; s < 4; ++s) {
                const bf16x8 rf = *(const LAS bf16x8*)(Rl + off_b(16 * et + l15, 4 * s + g4));
                oacc[et] = __builtin_amdgcn_mfma_f32_16x16x32_bf16(rf, qf[s], oacc[et], 0, 0, 0);
            }
        float sm = 0.f;
#pragma unroll
        for (int et = 0; et < 16; ++et) sm += (oacc[et][0] + oacc[et][1]) + (oacc[et][2] + oacc[et][3]);
        sm += __shfl_xor(sm, 16); sm += __shfl_xor(sm, 32);
        const float mean = sm * (1.0f / 256.0f);
        float sq = 0.f;
#pragma unroll
        for (int et = 0; et < 16; ++et) { const f32x4 dv = oacc[et] - mean; sq += (dv[0] * dv[0] + dv[1] * dv[1]) + (dv[2] * dv[2] + dv[3] * dv[3]); }
        sq += __shfl_xor(sq, 16); sq += __shfl_xor(sq, 32);
        const float rstd = 1.0f / sqrtf(sq * (1.0f / 256.0f) + NORM_EPS);
        const bf16_t* grow = RB + qrow * N_RET + 2048 + h * 256 + 4 * g4;
        bf16_t* orow = RETN + qrow * 1024 + h * 256 + 4 * g4;
        u32x2 gwv[16];
#pragma unroll
        for (int et = 0; et < 16; ++et) gwv[et] = *(const u32x2*)(grow + 16 * et);
#pragma unroll
        for (int et = 0; et < 16; ++et) {
            const u32x2 gw = gwv[et];
            const f32x4 y = (oacc[et] - mean) * rstd;
            u32x2 ow; ow.x = pk2(y[0] * bflo(gw.x), y[1] * bfhi(gw.x)); ow.y = pk2(y[2] * bflo(gw.y), y[3] * bfhi(gw.y));
            *(u32x2*)(orow + 16 * et) = ow;
        }
    }
}

__device__ __forceinline__ void router_phase(Frame& F) {
    const float* X1 = (const float*)F.dout;
    const float* wrl = (const float*)(F.ws + WS_WRL);
    const float* b_router = F.in[9];
    float* RSTD = (float*)(F.ws + WS_RSTD);
    unsigned* X1Q = (unsigned*)(F.ws + DY_X1B);
    int* asg_e = (int*)(F.ws + WS_ASG); float* asg_w = (float*)(F.ws + WS_ASG + 1 * MiB); int* asg_idx = (int*)(F.ws + WS_ASG + 2 * MiB);
    unsigned* gcnt = (unsigned*)(F.ws + WS_CTL) + CW_GCNT;
    LAS f32x4* WL = (LAS f32x4*)F.lds;
    LAS unsigned* hist = (LAS unsigned*)(F.lds + LDS_AUX);
    LAS unsigned* basel = hist + 32;
    LAS unsigned char* lds_e = (LAS unsigned char*)(F.lds + LDS_AUX + 256);
    LAS unsigned short* lds_rank = (LAS unsigned short*)(F.lds + LDS_AUX + 1280);
    const int lane = F.lane, w = F.wave, g4 = lane >> 4, l15 = lane & 15;
    __syncthreads();
    for (int i = F.tid; i < 8192; i += 512) WL[i] = ((const f32x4*)wrl)[i];
    if (F.tid < 32) hist[F.tid] = 0u;
    __syncthreads();
    for (int tb = blockIdx.x; tb < 256; tb += F.G) {
        const int half = tb >> 7;
#pragma unroll 1
        for (int it = 0; it < 2; ++it) {
            const int rg = 2 * w + it, row0 = tb * 256 + rg * 16;
            const float* xr = X1 + (size_t)(row0 + l15) * DM + 4 * g4;
            f32x4 acc0 = {0.f, 0.f, 0.f, 0.f}, acc1 = {0.f, 0.f, 0.f, 0.f}; float ss = 0.f, amax = 0.f;
#pragma unroll 1
            for (int ib = 0; ib < 8; ++ib) {
                f32x4 xv[8];
#pragma unroll
                for (int ii = 0; ii < 8; ++ii) xv[ii] = *(const f32x4*)(xr + 16 * (8 * ib + ii));
#pragma unroll
                for (int ii = 0; ii < 8; ++ii) {
                    const int i = 8 * ib + ii;
                    const f32x4 w0 = WL[(i * 4 + g4) * 32 + l15], w1 = WL[(i * 4 + g4) * 32 + 16 + l15];
#pragma unroll
                    for (int c = 0; c < 4; ++c) {
                        ss += xv[ii][c] * xv[ii][c]; amax = fmaxf(amax, fabsf(xv[ii][c]));
                        acc0 = __builtin_amdgcn_mfma_f32_16x16x4f32(xv[ii][c], w0[c], acc0, 0, 0, 0);
                        acc1 = __builtin_amdgcn_mfma_f32_16x16x4f32(xv[ii][c], w1[c], acc1, 0, 0, 0);
                    }
                }
            }
            ss += __shfl_xor(ss, 16); ss += __shfl_xor(ss, 32);
            const float rs = 1.0f / sqrtf(ss * (1.0f / DM) + NORM_EPS);
            amax = fmaxf(amax, __shfl_xor(amax, 16)); amax = fmaxf(amax, __shfl_xor(amax, 32));
            const float qinv = amax > 0.f ? 127.0f / amax : 0.f;
            if (lane < 16) RSTD[row0 + lane] = rs * amax * (1.0f / 127.0f);
#pragma unroll 1
            for (int ib = 0; ib < 8; ++ib) {
                f32x4 xq[8];
#pragma unroll
                for (int ii = 0; ii < 8; ++ii) xq[ii] = *(const f32x4*)(xr + 16 * (8 * ib + ii));
#pragma unroll
                for (int ii = 0; ii < 8; ++ii) {
                    const int q0 = __float2int_rn(xq[ii][0] * qinv), q1 = __float2int_rn(xq[ii][1] * qinv), q2 = __float2int_rn(xq[ii][2] * qinv), q3 = __float2int_rn(xq[ii][3] * qinv);
                    X1Q[(size_t)(row0 + l15) * 256 + 4 * (8 * ib + ii) + g4] = (unsigned)(q0 & 255) | ((unsigned)(q1 & 255) << 8) | ((unsigned)(q2 & 255) << 16) | ((unsigned)q3 << 24);
                }
            }
            const float b0 = b_router[l15], b1 = b_router[16 + l15];
#pragma unroll
            for (int rgi = 0; rgi < 4; ++rgi) {
                const float rr = __shfl(rs, 4 * g4 + rgi);
                float v0 = acc0[rgi] * rr + b0, v1 = acc1[rgi] * rr + b1;
                float pv[4]; int pi[4];
#pragma unroll
                for (int pk = 0; pk < 4; ++pk) {
                    float bv; int bi;
                    if (v0 >= v1) { bv = v0; bi = l15; } else { bv = v1; bi = 16 + l15; }
#pragma unroll
                    for (int o = 1; o < 16; o <<= 1) {
                        const float ov = __shfl_xor(bv, o); const int oi = __shfl_xor(bi, o);
                        if (ov > bv || (ov == bv && oi < bi)) { bv = ov; bi = oi; }
                    }
                    pv[pk] = bv; pi[pk] = bi;
                    if (bi == l15) v0 = -3.0e38f;
                    if (bi == 16 + l15) v1 = -3.0e38f;
                }
                if (l15 == 0) {
                    const float e1 = __expf(pv[1] - pv[0]), e2 = __expf(pv[2] - pv[0]), e3 = __expf(pv[3] - pv[0]);
                    const float inv = 1.0f / (1.0f + e1 + e2 + e3);
                    const float gt[4] = {inv, e1 * inv, e2 * inv, e3 * inv};
                    const int tl = rg * 16 + 4 * g4 + rgi, tok = tb * 256 + tl;
#pragma unroll
                    for (int pk = 0; pk < 4; ++pk) {
                        const unsigned rk = atomicAdd((unsigned*)&hist[pi[pk]], 1u);
                        lds_e[tl * 4 + pk] = (unsigned char)pi[pk]; lds_rank[tl * 4 + pk] = (unsigned short)rk;
                        asg_w[tok * 4 + pk] = gt[pk];
                    }
                }
            }
        }
        __syncthreads();
        if (F.tid < 32) { basel[F.tid] = atomicAdd(&gcnt[half * 32 + F.tid], hist[F.tid]); }
        __syncthreads();
        for (int a = F.tid; a < 1024; a += 512) {
            const int e = lds_e[a];
            asg_e[tb * 1024 + a] = e; asg_idx[tb * 1024 + a] = (int)(basel[e] + lds_rank[a]);
        }
        __syncthreads();
        if (F.tid < 32) hist[F.tid] = 0u;
        __syncthreads();
    }
}
__device__ __forceinline__ void scatter_phase(Frame& F) {
    const unsigned* gcnt = (const unsigned*)(F.ws + WS_CTL) + CW_GCNT;
    const float* RSTD = (const float*)(F.ws + WS_RSTD);
    const int* asg_e = (const int*)(F.ws + WS_ASG); const float* asg_w = (const float*)(F.ws + WS_ASG + 1 * MiB); const int* asg_idx = (const int*)(F.ws + WS_ASG + 2 * MiB);
    int* asg_pos = (int*)(F.ws + WS_ASG + 3 * MiB);
    int* tile_expert = (int*)(F.ws + WS_TILE);
    LAS int* seg = (LAS int*)(F.lds + LDS_AUX);
    LAS int* cntl = seg + 64;
    __syncthreads();
    if (F.tid < 2) {
        int run = 0;
        for (int e = 0; e < 32; ++e) { const int c = (int)__hip_atomic_load(&gcnt[F.tid * 32 + e], __ATOMIC_RELAXED, __HIP_MEMORY_SCOPE_AGENT); seg[F.tid * 32 + e] = run; cntl[F.tid * 32 + e] = c; run += (c + 255) & ~255; }
        if (blockIdx.x == 0) tile_expert[2 * HALF_TILES + F.tid] = run >> 8;
    }
    __syncthreads();
    const int gt = blockIdx.x * 512 + F.tid, NGT = F.G * 512;
    for (int a = gt; a < T_TOK * 4; a += NGT) {
        const int tok = a >> 2, half = tok >> 15, e = asg_e[a];
        const int pos = seg[half * 32 + e] + asg_idx[a];
        int* tokS = (int*)(F.ws + WS_SORT + (size_t)half * 3 * HALF_ROWS * 4); float* wS = (float*)(tokS + HALF_ROWS); float* rS = wS + HALF_ROWS;
        tokS[pos] = tok; wS[pos] = asg_w[a]; rS[pos] = RSTD[tok]; asg_pos[a] = pos;
    }
    for (int j = blockIdx.x; j < 64; j += F.G) {
        const int half = j >> 5, e = j & 31, s0 = seg[j], c = cntl[j], pe = (c + 255) & ~255;
        int* tokS = (int*)(F.ws + WS_SORT + (size_t)half * 3 * HALF_ROWS * 4); float* wS = (float*)(tokS + HALF_ROWS); float* rS = wS + HALF_ROWS;
        for (int i = c + F.tid; i < pe; i += 512) { tokS[s0 + i] = half * HALF_TOK; wS[s0 + i] = 0.f; rS[s0 + i] = 0.f; }
        for (int t = F.tid; t < (pe >> 8); t += 512) tile_expert[half * HALF_TILES + (s0 >> 8) + t] = e;
    }
}
__device__ __forceinline__ void final_phase(Frame& F, int half) {
    float* X1 = (float*)F.dout;
    const bf16_t* Y = (const bf16_t*)(F.ws + DY_Y);
    const int* asg_pos = (const int*)(F.ws + WS_ASG + 3 * MiB);
    const float* gfin = F.in[14];
    const int gw = blockIdx.x * 8 + F.wave, NGW = F.G * 8;
    for (int m0 = half * HALF_TOK + 2 * gw; m0 < (half + 1) * HALF_TOK; m0 += 2 * NGW) {
        int pos[2][4]; f32x4 v[2][4]; u32x2 yw[2][4][4];
#pragma unroll
        for (int r = 0; r < 2; ++r)
#pragma unroll
            for (int k = 0; k < 4; ++k) pos[r][k] = asg_pos[(m0 + r) * 4 + k];
#pragma unroll
        for (int r = 0; r < 2; ++r)
#pragma unroll
            for (int j = 0; j < 4; ++j) {
                v[r][j] = ((const f32x4*)(X1 + (size_t)(m0 + r) * DM) + F.lane)[64 * j];
#pragma unroll
                for (int k = 0; k < 4; ++k) yw[r][j][k] = *((const u32x2*)(Y + (size_t)pos[r][k] * DM) + F.lane + 64 * j);
            }
        float s[2] = {0.f, 0.f};
#pragma unroll
        for (int r = 0; r < 2; ++r)
#pragma unroll
            for (int j = 0; j < 4; ++j) {
#pragma unroll
                for (int k = 0; k < 4; ++k) { v[r][j][0] += bflo(yw[r][j][k].x); v[r][j][1] += bfhi(yw[r][j][k].x); v[r][j][2] += bflo(yw[r][j][k].y); v[r][j][3] += bfhi(yw[r][j][k].y); }
                s[r] += (v[r][j][0] * v[r][j][0] + v[r][j][1] * v[r][j][1]) + (v[r][j][2] * v[r][j][2] + v[r][j][3] * v[r][j][3]);
            }
#pragma unroll
        for (int r = 0; r < 2; ++r) {
            const float rstd = 1.0f / sqrtf(wave_sum(s[r]) * (1.0f / DM) + NORM_EPS);
            f32x4* xr = (f32x4*)(X1 + (size_t)(m0 + r) * DM) + F.lane;
#pragma unroll
            for (int j = 0; j < 4; ++j) { const f32x4 gg = *((const f32x4*)gfin + F.lane + 64 * j); xr[64 * j] = v[r][j] * rstd * gg; }
        }
    }
}

constexpr int N_PHASES = 17;
__global__ void __launch_bounds__(512, 2) mk_fwd(Args args) {
    extern __shared__ __attribute__((aligned(16))) unsigned char lds_raw[];
    Frame F;
    F.lds = (LAS unsigned char*)lds_raw;
    F.tid = threadIdx.x; F.lane = F.tid & 63; F.wave = __builtin_amdgcn_readfirstlane(F.tid >> 6); F.G = gridDim.x;
    F.ws = args.ws; F.dout = (unsigned char*)args.out;
#pragma unroll
    for (int i = 0; i < 15; ++i) F.in[i] = args.in[i];
    volatile LAS unsigned* MISC = (volatile LAS unsigned*)(F.lds + LDS_MISC);
    if (F.tid < 64) MISC[F.tid] = 0u;
    __syncthreads();
    XcdBarrier bar; bar.bar = (unsigned*)(F.ws + WS_CTL) + CW_BAR; bar.x = 0; bar.st = nullptr;
    if (!MK_PER_PHASE) bar = xcd_barrier_post((unsigned*)(F.ws + WS_CTL) + CW_BAR, MISC + 8);
    const int lo = args.ph_lo, hi = args.ph_hi;
#define IN(k) (lo <= (k) && (k) < hi)
#define SEAM(k) do { if (IN(k) && IN((k) + 1)) xcd_barrier(bar); } while (0)
    using namespace pg8;
    const float* rope = (const float*)(F.ws + WS_ROPE);
    const int c = (int)blockIdx.x;

    if (IN(0)) { p0_prologue(F); } SEAM(0);
    if (IN(1)) {
        SchedDense S{T_TOK / 256, N_ATT / 256, F.G, c, 512, (const char*)(F.ws + WS_WINQ)};
        EpiProj<0> E{(bf16_t*)(F.ws + DY_ATTBUF), N_ATT, rope, (const float*)(F.ws + WS_RS0), (const float*)(F.ws + WS_SWIN)};
        gemm_phase<EpiProj<0>, SchedDense, true>(F.lds, (const char*)(F.dout + DO_HBQ), S, E);
    } SEAM(1);
    if (IN(2)) { attn_phase(F, 0); } SEAM(2);
    if (IN(3)) { attn_phase(F, 1); } SEAM(3);
    if (IN(4)) { attn_phase(F, 2); } SEAM(4);
    if (IN(5)) {
        { SchedDense S{T_TOK / 256, N_GATE / 256, F.G, c, 512, (const char*)(F.ws + WS_WINQ) + (size_t)7680 * 1024};
          EpiProj<0> E{(bf16_t*)(F.ws + DY_GATEBUF), N_GATE, rope, (const float*)(F.ws + WS_RS0), (const float*)(F.ws + WS_SWIN) + 7680};
          gemm_phase<EpiProj<0>, SchedDense, true>(F.lds, (const char*)(F.dout + DO_HBQ), S, E); }
        { SchedDense S{T_TOK / 256, N_RET / 256, F.G, c, 512, (const char*)(F.ws + WS_WINQ) + (size_t)4608 * 1024};
          EpiProj<2> E{(bf16_t*)(F.ws + DY_RETBUF), N_RET, rope, (const float*)(F.ws + WS_RS0), (const float*)(F.ws + WS_SWIN) + 4608};
          gemm_phase<EpiProj<2>, SchedDense, true>(F.lds, (const char*)(F.dout + DO_HBQ), S, E); }
    } SEAM(5);
    if (IN(6)) { ret_state_phase(F); } SEAM(6);
    if (IN(7)) { ret_out_phase(F); } SEAM(7);
    if (IN(8)) {
        { SchedDense S{T_TOK / 256, 4, F.G, c, 512, (const char*)(F.ws + WS_WATT)};
          EpiM1 E{(bf16_t*)(F.ws + DY_M1), (const bf16_t*)(F.ws + DY_GATEBUF)};
          gemm_phase(F.lds, (const char*)(F.ws + DY_ATT), S, E); }
        VM_WAIT(); __syncthreads();
        { SchedDense S{T_TOK / 256, 4, F.G, c, 1024, (const char*)(F.ws + WS_WRET)};
          EpiMerge E{(bf16_t*)(F.ws + DY_MERGED), (const bf16_t*)(F.ws + DY_GATEBUF), (const bf16_t*)(F.ws + DY_M1)};
          gemm_phase(F.lds, (const char*)(F.dout + DO_RETN), S, E); }
    } SEAM(8);
    if (IN(9)) {
        SchedDense S{T_TOK / 256, 4, F.G, c, 1024, (const char*)(F.ws + WS_WOUT)};
        EpiX1 E{F.in[0], (float*)F.dout};
        gemm_phase(F.lds, (const char*)(F.ws + DY_MERGED), S, E);
    } SEAM(9);
    if (IN(10)) { router_phase(F); } SEAM(10);
    if (IN(11)) { scatter_phase(F); } SEAM(11);
#define MOE_UP(half) do { \
        const int* tileE = (const int*)(F.ws + WS_TILE) + (half) * HALF_TILES; const int ntl = __builtin_amdgcn_readfirstlane(((const int*)(F.ws + WS_TILE))[2 * HALF_TILES + (half)]); \
        const int* tokS = (const int*)(F.ws + WS_SORT + (size_t)(half) * 3 * HALF_ROWS * 4); \
        SchedMoE S{ntl, 8, F.G, c, 512, (const char*)(F.ws + WS_W1), (size_t)2048 * 1024, tileE, tokS}; \
        EpiSwiglu E{(bf16_t*)(F.ws + DY_ACT), F.in[11], (const float*)(tokS + 2 * HALF_ROWS), (const float*)(F.ws + WS_SW1)}; \
        gemm_phase<EpiSwiglu, SchedMoE, true>(F.lds, (const char*)(F.ws + DY_X1B), S, E); } while (0)
#define MOE_DOWN(half) do { \
        const int* tileE = (const int*)(F.ws + WS_TILE) + (half) * HALF_TILES; const int ntl = __builtin_amdgcn_readfirstlane(((const int*)(F.ws + WS_TILE))[2 * HALF_TILES + (half)]); \
        const int* tokS = (const int*)(F.ws + WS_SORT + (size_t)(half) * 3 * HALF_ROWS * 4); \
        SchedMoE S{ntl, 4, F.G, c, 512, (const char*)(F.ws + WS_W2), (size_t)1024 * 1024, tileE, nullptr}; \
        EpiDown E{(bf16_t*)(F.ws + DY_Y), F.in[13], (const float*)(tokS + HALF_ROWS), (const float*)(F.ws + WS_SW2)}; \
        gemm_phase<EpiDown, SchedMoE, true>(F.lds, (const char*)(F.ws + DY_ACT), S, E); } while (0)
    if (IN(12)) { MOE_UP(0); } SEAM(12);
    if (IN(13)) { MOE_DOWN(0); } SEAM(13);
    if (IN(14)) { final_phase(F, 0); MOE_UP(1); } SEAM(14);
    if (IN(15)) { MOE_DOWN(1); } SEAM(15);
    if (IN(16)) { final_phase(F, 1); }
#undef IN
#undef SEAM
}


extern "C" void kernel_launch(void* const* d_in, const int* in_sizes, int n_in, void* d_out, int out_size, void* d_ws, size_t ws_size, hipStream_t stream) {
    static int grid = 0;
    if (grid == 0) {
        if (n_in != 15 || out_size != T_TOK * DM || ws_size < WS_END) { fprintf(stderr, "kernel_launch: unexpected shapes (n_in %d out %d ws %zu)\n", n_in, out_size, ws_size); grid = -1; return; }
        int dev = 0, cus = 0, per_cu = 0;
        if (hipGetDevice(&dev) != hipSuccess || hipDeviceGetAttribute(&cus, hipDeviceAttributeMultiprocessorCount, dev) != hipSuccess) { grid = -1; return; }
        if (hipFuncSetAttribute((const void*)mk_fwd, hipFuncAttributeMaxDynamicSharedMemorySize, LDS_BYTES) != hipSuccess) { fprintf(stderr, "kernel_launch: hipFuncSetAttribute failed\n"); grid = -1; return; }
        if (hipOccupancyMaxActiveBlocksPerMultiprocessor(&per_cu, (const void*)mk_fwd, 512, LDS_BYTES) != hipSuccess || per_cu < 1) { fprintf(stderr, "kernel_launch: occupancy query says %d\n", per_cu); }
        (void)hipGetLastError();
        grid = cus;
    }
    if (grid < 0) return;
    (void)hipMemsetAsync((char*)d_ws + WS_CTL, 0, CTL_BYTES, stream);
    Args a{};
    for (int i = 0; i < 15; ++i) a.in[i] = (const float*)d_in[i];
    a.out = (float*)d_out; a.ws = (unsigned char*)d_ws;
#if MK_PER_PHASE
    for (int p = 0; p < N_PHASES; ++p) { a.ph_lo = p; a.ph_hi = p + 1; hipLaunchKernelGGL(mk_fwd, dim3(grid), dim3(512), LDS_BYTES, stream, a); }
#else
    a.ph_lo = 0; a.ph_hi = N_PHASES;
    hipLaunchKernelGGL(mk_fwd, dim3(grid), dim3(512), LDS_BYTES, stream, a);
#endif
}
```

```cpp
#include <hip/hip_runtime.h>
#include <cstdio>
#include <cstdint>

#ifndef MK_PER_PHASE
#define MK_PER_PHASE 0
#endif

#define GAS __attribute__((address_space(1)))
#define LAS __attribute__((address_space(3)))
typedef unsigned short bf16_t;
typedef short bf16x8 __attribute__((ext_vector_type(8)));
typedef short s16x4 __attribute__((ext_vector_type(4)));
typedef float f32x4 __attribute__((ext_vector_type(4)));
typedef float f32x2 __attribute__((ext_vector_type(2)));
typedef unsigned u32x4 __attribute__((ext_vector_type(4)));
typedef unsigned u32x2 __attribute__((ext_vector_type(2)));
typedef int i32x4 __attribute__((ext_vector_type(4)));

constexpr int T_TOK = 65536, DM = 1024, SEQ = 4096, NB = 16;
constexpr int N_ATT = 4608, N_RET = 3072, N_GATE = 2048, PROJ_W = 9728;
constexpr int NEXP = 32, TOPK = 4, DEXP = 1024;
constexpr int HALF_TOK = 65536, HALF_ROWS = 270336, HALF_TILES = 1056;
constexpr float NORM_EPS = 1e-5f;
constexpr float LOG2E = 1.4426950408889634f;

constexpr size_t MiB = 1u << 20;
constexpr size_t WS_CTL = 0, CTL_BYTES = 1 * MiB;
constexpr size_t WS_ROPE = 1 * MiB;
constexpr size_t WS_BIAS = 3 * MiB;
constexpr size_t WS_WRL = 3 * MiB + 65536;
constexpr size_t WS_RSTD = 4 * MiB;
constexpr size_t WS_ASG = 5 * MiB;
constexpr size_t WS_SORT = 9 * MiB;
constexpr size_t WS_TILE = 13 * MiB;
constexpr size_t WS_LSE = 14 * MiB;
constexpr size_t WS_WATT = 16 * MiB;
constexpr size_t WS_WRET = 17 * MiB;
constexpr size_t WS_WOUT = 19 * MiB;
constexpr size_t WS_WIN = 21 * MiB;
constexpr size_t WS_W1 = 40 * MiB;
constexpr size_t WS_SW1 = 104 * MiB;
constexpr size_t WS_WINQ = 112 * MiB;
constexpr size_t WS_SWIN = 124 * MiB;
constexpr size_t WS_RS0 = 4 * MiB + 512 * 1024;
constexpr size_t WS_W2 = 168 * MiB;
constexpr size_t WS_SW2 = 125 * MiB;
constexpr float ACT_STEP = 12.0f / 127.0f;
constexpr size_t WS_DYN = 232 * MiB;
constexpr size_t DY_ATTBUF = WS_DYN;
constexpr size_t DY_ATT = WS_DYN + 720 * MiB;
constexpr size_t DY_RETBUF = WS_DYN;
constexpr size_t DY_GATEBUF = WS_DYN + 384 * MiB;
constexpr size_t DY_M1 = WS_DYN;
constexpr size_t DY_MERGED = WS_DYN + 128 * MiB;
constexpr size_t DY_X1B = 200 * MiB;
constexpr size_t DY_ACT = 728 * MiB;
constexpr size_t DY_Y = 200 * MiB;
constexpr size_t WS_END = WS_DYN + 792 * MiB;
static_assert(DY_Y + (size_t)HALF_ROWS * 2048 <= DY_ACT && DY_ACT + (size_t)HALF_ROWS * 1024 <= WS_END && WS_W2 + (size_t)NEXP * 1024 * 1024 <= DY_Y, "ws map");
static_assert(DY_ATTBUF + (size_t)T_TOK * N_ATT * 2 <= DY_ATT, "ws map");
constexpr size_t DO_HB = 0, DO_SR = 0, DO_RETN = 128 * MiB, DO_HBQ = 128 * MiB;

constexpr int CW_BAR = 1024;
constexpr int CW_GCNT = 8192;

constexpr int LDS_MAIN = 131072;
constexpr int LDS_AUX = LDS_MAIN;
constexpr int LDS_MISC = LDS_MAIN + 7168;
constexpr int LDS_BYTES = LDS_MAIN + 8192;

__device__ __forceinline__ float bf2f(unsigned short b) { return __uint_as_float(((unsigned)b) << 16); }
typedef __bf16 bf16x2_t __attribute__((ext_vector_type(2)));
__device__ __forceinline__ unsigned pk2(float lo, float hi) { const f32x2 v = {lo, hi}; const bf16x2_t b = __builtin_convertvector(v, bf16x2_t); return __builtin_bit_cast(unsigned, b); }
__device__ __forceinline__ float bflo(unsigned w) { return __uint_as_float(w << 16); }
__device__ __forceinline__ float bfhi(unsigned w) { return __uint_as_float(w & 0xffff0000u); }
__device__ __forceinline__ float fast_exp2(float x) { return __builtin_amdgcn_exp2f(x); }
__device__ __forceinline__ float fast_rcp(float x) { return __builtin_amdgcn_rcpf(x); }
__device__ __forceinline__ float sigmoidf_(float x) { return fast_rcp(1.0f + fast_exp2(-x * LOG2E)); }
__device__ __forceinline__ float wave_sum(float v) {
#pragma unroll
    for (int o = 1; o < 64; o <<= 1) v += __shfl_xor(v, o);
    return v;
}
#define LDS_WAIT() asm volatile("s_waitcnt lgkmcnt(0)" ::: "memory")
#define VM_WAIT() asm volatile("s_waitcnt vmcnt(0)" ::: "memory")

__device__ __forceinline__ unsigned off_b(unsigned row, unsigned ch) { return 256u * row + 16u * (ch ^ (((row & 3u) << 2) | ((row >> 2) & 3u))); }
__device__ __forceinline__ s16x4 tr_read(const LAS unsigned char* p) { return __builtin_amdgcn_ds_read_tr16_b64_v4i16((LAS s16x4*)p); }
__device__ __forceinline__ bf16x8 cat8(s16x4 a, s16x4 b) { return __builtin_shufflevector(a, b, 0, 1, 2, 3, 4, 5, 6, 7); }

#define XB_TMO      128
#define XB_XCNT(j)  (256  + 64 * (j))
#define XB_XSUB(j)  (1280 + 64 * (j))
#define XB_XGEN(j)  (2304 + 64 * (j))
#define XB_TOP      3328
#define XB_TOPGEN   3392
#define XCD_BAR_WORDS 3456
#define XB_SPIN_CAP (1u << 18)
__device__ __forceinline__ unsigned xb_ld(unsigned* p)              { return __hip_atomic_load(p, __ATOMIC_RELAXED, __HIP_MEMORY_SCOPE_AGENT); }
__device__ __forceinline__ unsigned xb_add(unsigned* p, unsigned v) { return __hip_atomic_fetch_add(p, v, __ATOMIC_RELAXED, __HIP_MEMORY_SCOPE_AGENT); }
__device__ __forceinline__ unsigned xb_xcc_id() { return (unsigned)__builtin_amdgcn_s_getreg((3 << 11) | 20) & 0xFu; }
#define XB_SPIN(cond, bar) do { unsigned _sp = 0; while (cond) { __builtin_amdgcn_s_sleep(1); \
    if ((++_sp & 255u) == 0u) { if (xb_ld(&(bar)[XB_TMO])) break; if (_sp > XB_SPIN_CAP) { atomicAdd(&(bar)[XB_TMO], 1u); break; } } } } while (0)
struct XcdBarrier { unsigned* bar; unsigned x; volatile LAS unsigned* st; };
__device__ __forceinline__ XcdBarrier xcd_barrier_post(unsigned* bar, volatile LAS unsigned* st) {
    XcdBarrier b; b.bar = bar; b.x = xb_xcc_id(); b.st = st;
    if (threadIdx.x == 0) (void)xb_add(&bar[XB_XCNT(b.x)], 1u);
    return b;
}
__device__ __forceinline__ void xcd_barrier_complete(unsigned* bar, unsigned x, unsigned& nloc, unsigned& nx) {
    const unsigned G = gridDim.x * gridDim.y * gridDim.z;
    unsigned sum, cnt, mine, sp = 0u;
    for (;;) {
        sum = 0u; cnt = 0u; mine = 0u;
#pragma unroll
        for (unsigned j = 0; j < 16; ++j) { const unsigned c = xb_ld(&bar[XB_XCNT(j)]); sum += c; cnt += (c > 0u) ? 1u : 0u; mine = (j == x) ? c : mine; }
        if (sum == G) break;
        __builtin_amdgcn_s_sleep(1);
        if ((++sp & 255u) == 0u) { if (xb_ld(&bar[XB_TMO])) break; if (sp > XB_SPIN_CAP) { atomicAdd(&bar[XB_TMO], 1u); break; } }
    }
    nloc = mine > 0u ? mine : 1u; nx = cnt > 0u ? cnt : 1u;
}
__device__ __forceinline__ void xcd_barrier(const XcdBarrier& b) {
    asm volatile("s_waitcnt vmcnt(0)" ::: "memory");
    __syncthreads();
    if (threadIdx.x == 0) {
        unsigned* bar = b.bar;
        __builtin_amdgcn_s_waitcnt(0);
        unsigned nloc = b.st[0], nx = b.st[1];
        if (nloc == 0u) { xcd_barrier_complete(bar, b.x, nloc, nx); b.st[0] = nloc; b.st[1] = nx; }
        const unsigned old = xb_add(&bar[XB_XSUB(b.x)], 1u);
        const unsigned gen = old / nloc;
        if (old + 1u == (gen + 1u) * nloc) {
            __builtin_amdgcn_fence(__ATOMIC_RELEASE, "agent");
            asm volatile("s_waitcnt vmcnt(0)" ::: "memory");
            const unsigned og = xb_add(&bar[XB_TOP], 1u);
            const unsigned tg = og / nx;
            if (og + 1u == (tg + 1u) * nx) xb_add(&bar[XB_TOPGEN], 1u);
            else XB_SPIN(xb_ld(&bar[XB_TOPGEN]) == tg, bar);
            __builtin_amdgcn_fence(__ATOMIC_ACQUIRE, "agent");
            xb_add(&bar[XB_XGEN(b.x)], 1u);
            asm volatile("s_waitcnt vmcnt(0)" ::: "memory");
        } else {
            XB_SPIN(xb_ld(&bar[XB_XGEN(b.x)]) == gen, bar);
            __builtin_amdgcn_fence(__ATOMIC_ACQUIRE, "agent");
            asm volatile("s_waitcnt vmcnt(0)" ::: "memory");
        }
    }
    __syncthreads();
}

namespace pg8 {
constexpr int BM = 256, BK = 64, HALF = 128, HTB = HALF * BK * 2, STAGE_BYTES = 8 * HTB, NXCD = 8, WGM = 8;
__device__ __forceinline__ int lds_byte(int r, int c) { const int st = (r >> 4) * 2 + (c >> 5), rr = r & 15, cc = c & 31, ob = rr * 64 + cc * 2; return st * 1024 + (ob ^ (((ob >> 9) & 1) << 5)); }
__device__ __forceinline__ void stage_rc(int b, int& R, int& C) { const int st = b / 1024, sb = b % 1024, swz = sb ^ (((sb >> 9) & 1) << 5); R = (st >> 1) * 16 + swz / 64; C = (st & 1) * 32 + (swz % 64) / 2; }
__device__ __forceinline__ int perm32(int rho) { const int n = rho >> 4, i = rho & 15; return 8 * (i >> 2) + 4 * n + (i & 3); }
struct Unit { int pm, pn, e; };

__device__ __forceinline__ bool unit_of(long L, int nM, int nN, Unit& u) {
    const int nwg = nM * nN; if (L >= nwg) return false;
    int wgid = (int)L; { const int q = nwg / NXCD, r = nwg % NXCD, xcd = wgid % NXCD, off = wgid / NXCD; wgid = (xcd < r ? xcd * (q + 1) : r * (q + 1) + (xcd - r) * q) + off; }
    const int nig = WGM * nN, gid = wgid / nig, fm = gid * WGM, gsz = (nM - fm) < WGM ? (nM - fm) : WGM;
    u.pm = fm + ((wgid % nig) % gsz); u.pn = (wgid % nig) / gsz; u.e = 0; return true;
}
struct SchedDense {
    int nM, nN, G, c, K; const char* Bt;
    __device__ __forceinline__ bool next(int i, Unit& u) const { return unit_of((long)i * G + c, nM, nN, u); }
    __device__ __forceinline__ const char* bbase(const Unit& u) const { return Bt + (size_t)u.pn * 256 * K * 2; }
    __device__ __forceinline__ void aoff(const Unit& u, const int (&R)[2], const int (&C)[2], unsigned (&v)[2][2]) const {
#pragma unroll
        for (int h = 0; h < 2; ++h)
#pragma unroll
            for (int i = 0; i < 2; ++i) v[h][i] = (unsigned)((u.pm * 256 + h * 128 + R[i]) * K + C[i]) * 2u;
    }
};
struct SchedMoE {
    int nM, nN, G, c, K; const char* Bt; size_t estride; const int* tile_expert; const int* rowidx;
    __device__ __forceinline__ bool next(int i, Unit& u) const { if (!unit_of((long)i * G + c, nM, nN, u)) return false; u.e = __builtin_amdgcn_readfirstlane(tile_expert[u.pm]); return true; }
    __device__ __forceinline__ const char* bbase(const Unit& u) const { return Bt + (size_t)u.e * estride + (size_t)u.pn * 256 * K * 2; }
    __device__ __forceinline__ void aoff(const Unit& u, const int (&R)[2], const int (&C)[2], unsigned (&v)[2][2]) const {
#pragma unroll
        for (int h = 0; h < 2; ++h)
#pragma unroll
            for (int i = 0; i < 2; ++i) { const int r = u.pm * 256 + h * 128 + R[i]; const int src = rowidx ? rowidx[r] : r; v[h][i] = (unsigned)(src * K + C[i]) * 2u; }
    }
};

template <bool I8> struct AccSel { typedef f32x4 T; };
template <> struct AccSel<true> { typedef i32x4 T; };
template <class Epi, class Sched, bool I8 = false>
__device__ __forceinline__ void gemm_phase(LAS unsigned char* lds, const char* gA, const Sched& S, const Epi& E) {
    typedef typename AccSel<I8>::T acc_t;
    const int tid = threadIdx.x, wid = __builtin_amdgcn_readfirstlane(tid >> 6), lane = tid & 63, wr = wid >> 2, wc = wid & 3, fr = lane & 15, fq = lane >> 4;
    const int K = S.K, nt = K / BK;
    int Rr[2], Cc[2]; unsigned voffB[2];
#pragma unroll
    for (int i = 0; i < 2; ++i) { int R, C; stage_rc(tid * 16 + i * 8192, R, C); Rr[i] = R; Cc[i] = C; const int Rb = (R & ~31) + perm32(R & 31); voffB[i] = (unsigned)(Rb * K + C) * 2u; }
    const size_t kstep = (size_t)(BK * 2);
    const size_t hstep = (size_t)HALF * K * 2;
    const unsigned ldsw = (unsigned)wid * 1024u;
    const int aoff = lds_byte(wr * 64 + fr, fq * 8), boff = lds_byte(wc * 32 + fr, fq * 8);
#define PG8_SA(b, h) (((b) * 2 + (h)) * HTB)
#define PG8_SB(b, h) ((4 + (b) * 2 + (h)) * HTB)
#define PG8_STAGE_B(bufoff, gbase) do { _Pragma("unroll") for (int _i = 0; _i < 2; ++_i) \
        __builtin_amdgcn_global_load_lds((const unsigned*)((const char*)(gbase) + voffB[_i]), (LAS unsigned*)(lds + (bufoff) + ldsw + _i * 8192), 16, 0, 0); } while (0)
#define PG8_STAGE_A(bufoff, gbase, vv) do { _Pragma("unroll") for (int _i = 0; _i < 2; ++_i) \
        __builtin_amdgcn_global_load_lds((const unsigned*)((const char*)(gbase) + (vv)[_i]), (LAS unsigned*)(lds + (bufoff) + ldsw + _i * 8192), 16, 0, 0); } while (0)
#define PG8_LDA(dst, b, h) do { _Pragma("unroll") for (int m = 0; m < 4; ++m) _Pragma("unroll") for (int k = 0; k < 2; ++k) dst[m][k] = *(const LAS bf16x8*)(lds + PG8_SA(b, h) + aoff + m * 2048 + k * 1024); } while (0)
#define PG8_LDB(dst, b, h) do { _Pragma("unroll") for (int n = 0; n < 2; ++n) _Pragma("unroll") for (int k = 0; k < 2; ++k) dst[n][k] = *(const LAS bf16x8*)(lds + PG8_SB(b, h) + boff + n * 2048 + k * 1024); } while (0)
#define PG8_MMA(ai, bj, At, Bt) do { __builtin_amdgcn_s_setprio(1); _Pragma("unroll") for (int m = 0; m < 4; ++m) _Pragma("unroll") for (int n = 0; n < 2; ++n) _Pragma("unroll") for (int k = 0; k < 2; ++k) { \
        if constexpr (I8) acc[ai][bj][m][n] = __builtin_amdgcn_mfma_i32_16x16x64_i8(__builtin_bit_cast(i32x4, Bt[n][k]), __builtin_bit_cast(i32x4, At[m][k]), acc[ai][bj][m][n], 0, 0, 0); \
        else acc[ai][bj][m][n] = __builtin_amdgcn_mfma_f32_16x16x32_bf16(Bt[n][k], At[m][k], acc[ai][bj][m][n], 0, 0, 0); } __builtin_amdgcn_s_setprio(0); } while (0)
#define PG8_WAIT_V(n) asm volatile("s_waitcnt vmcnt(" #n ")" ::: "memory")
#define PG8_WAIT_L(n) asm volatile("s_waitcnt lgkmcnt(" #n ")" ::: "memory")
#define PG8_BAR __builtin_amdgcn_s_barrier()
#define PG8_SCHED __builtin_amdgcn_sched_barrier(0)
    Unit cur, nxt; int ui = 0;
    if (!S.next(0, cur)) return;
    const int ntm = nt - 1;
    int rc = (cur.pm + 2 * cur.pn) & ntm, rn = rc;
    acc_t acc[2][2][4][2];
#pragma unroll
    for (int a = 0; a < 2; ++a)
#pragma unroll
        for (int b = 0; b < 2; ++b)
#pragma unroll
            for (int m = 0; m < 4; ++m)
#pragma unroll
                for (int n = 0; n < 2; ++n) acc[a][b][m][n] = (acc_t){0, 0, 0, 0};
    bf16x8 At[4][2], B0[2][2], B1[2][2];
    unsigned vc[2][2], vn[2][2];
    S.aoff(cur, Rr, Cc, vc);
    const char* cB = S.bbase(cur);
    { const size_t k0 = (size_t)rc * kstep, k1 = (size_t)((rc + 1) & ntm) * kstep;
    PG8_STAGE_B(PG8_SB(0, 0), cB + k0); PG8_STAGE_B(PG8_SB(0, 1), cB + hstep + k0); PG8_STAGE_A(PG8_SA(0, 0), gA + k0, vc[0]); PG8_STAGE_A(PG8_SA(0, 1), gA + k0, vc[1]);
    PG8_STAGE_B(PG8_SB(1, 0), cB + k1); PG8_STAGE_B(PG8_SB(1, 1), cB + hstep + k1); PG8_STAGE_A(PG8_SA(1, 0), gA + k1, vc[0]); }
    if (wr == 1) PG8_BAR;
    PG8_WAIT_V(8); PG8_BAR; PG8_BAR;
    for (;;) {
        const bool has_next = S.next(ui + 1, nxt);
        const char* nB = cB;
        if (has_next) { S.aoff(nxt, Rr, Cc, vn); nB = S.bbase(nxt); rn = (nxt.pm + 2 * nxt.pn) & ntm; }
        else { rn = rc;
#pragma unroll
            for (int h = 0; h < 2; ++h)
#pragma unroll
                for (int i = 0; i < 2; ++i) vn[h][i] = vc[h][i];
        }
        for (int t = 0; t < nt; t += 2) {
            const bool last = (t == nt - 2);
            const size_t ko1 = (size_t)((rc + t + 1) & ntm) * kstep;
            const size_t ko2 = (size_t)(last ? rn : ((rc + t + 2) & ntm)) * kstep, ko3 = (size_t)(last ? ((rn + 1) & ntm) : ((rc + t + 3) & ntm)) * kstep;
            const char* a1 = gA + ko1;
            const char* a2 = gA + ko2;
            const char* a3 = gA + ko3;
            unsigned v2[2][2];
#pragma unroll
            for (int h = 0; h < 2; ++h)
#pragma unroll
                for (int i = 0; i < 2; ++i) v2[h][i] = last ? vn[h][i] : vc[h][i];
            const char* bb = last ? nB : cB;
            PG8_LDB(B0, 0, 0); PG8_LDB(B1, 0, 1); PG8_LDA(At, 0, 0); PG8_STAGE_A(PG8_SA(1, 1), a1, vc[1]);
            PG8_WAIT_V(8); PG8_WAIT_L(0); PG8_BAR; PG8_SCHED; PG8_MMA(0, 0, At, B0); PG8_MMA(0, 1, At, B1); PG8_BAR; PG8_SCHED;
            PG8_LDA(At, 0, 1); PG8_STAGE_B(PG8_SB(0, 0), bb + ko2); PG8_STAGE_B(PG8_SB(0, 1), bb + ko2 + hstep); PG8_STAGE_A(PG8_SA(0, 0), a2, v2[0]);
            PG8_WAIT_V(8); PG8_WAIT_L(0); PG8_BAR; PG8_SCHED; PG8_MMA(1, 0, At, B0); PG8_MMA(1, 1, At, B1); PG8_BAR; PG8_SCHED;
            PG8_LDB(B0, 1, 0); PG8_LDB(B1, 1, 1); PG8_LDA(At, 1, 0); PG8_STAGE_A(PG8_SA(0, 1), a2, v2[1]);
            PG8_WAIT_V(8); PG8_WAIT_L(0); PG8_BAR; PG8_SCHED; PG8_MMA(0, 0, At, B0); PG8_MMA(0, 1, At, B1); PG8_BAR; PG8_SCHED;
            PG8_LDA(At, 1, 1); PG8_STAGE_B(PG8_SB(1, 0), bb + ko3); PG8_STAGE_B(PG8_SB(1, 1), bb + ko3 + hstep); PG8_STAGE_A(PG8_SA(1, 0), a3, v2[0]);
            PG8_WAIT_V(8); PG8_WAIT_L(0); PG8_BAR; PG8_SCHED; PG8_MMA(1, 0, At, B0); PG8_MMA(1, 1, At, B1); PG8_BAR; PG8_SCHED;
        }
        E(acc, cur, wr, wc, fr, fq);
        if (!has_next) break;
#pragma unroll
        for (int a = 0; a < 2; ++a)
#pragma unroll
            for (int b = 0; b < 2; ++b)
#pragma unroll
                for (int m = 0; m < 4; ++m)
#pragma unroll
                    for (int n = 0; n < 2; ++n) acc[a][b][m][n] = (acc_t){0, 0, 0, 0};
        cur = nxt; cB = nB; rc = rn; ++ui;
#pragma unroll
        for (int h = 0; h < 2; ++h)
#pragma unroll
            for (int i = 0; i < 2; ++i) vc[h][i] = vn[h][i];
    }
    PG8_WAIT_V(0);
    if (wr == 0) PG8_BAR;
    PG8_BAR;
#undef PG8_SA
#undef PG8_SB
#undef PG8_STAGE_A
#undef PG8_STAGE_B
#undef PG8_LDA
#undef PG8_LDB
#undef PG8_MMA
#undef PG8_WAIT_V
#undef PG8_WAIT_L
#undef PG8_BAR
#undef PG8_SCHED
}

#define EPI_LOOP_BEGIN \
    _Pragma("unroll") for (int ai = 0; ai < 2; ++ai) _Pragma("unroll") for (int m = 0; m < 4; ++m) { const int row = u.pm * BM + ai * HALF + wr * 64 + m * 16 + fr; \
    _Pragma("unroll") for (int bj = 0; bj < 2; ++bj) { const int col = u.pn * BM + bj * HALF + wc * 32 + 8 * fq; f32x4 v0 = acc[ai][bj][m][0], v1 = acc[ai][bj][m][1];
#define EPI_LOOP_END } }
__device__ __forceinline__ u32x4 pack8(f32x4 v0, f32x4 v1) { u32x4 w; w.x = pk2(v0[0], v0[1]); w.y = pk2(v0[2], v0[3]); w.z = pk2(v1[0], v1[1]); w.w = pk2(v1[2], v1[3]); return w; }

template <int MODE> struct EpiProj {
    bf16_t* O; int ldc; const float* rope; const float* rs0; const float* sw;
    __device__ __forceinline__ void operator()(const i32x4 (&acc)[2][2][4][2], const Unit& u, int wr, int wc, int fr, int fq) const {
        const int row0 = u.pm * BM + wr * 64 + fr, colb = u.pn * BM + wc * 32 + 8 * fq;
        float rsr[8]; f32x4 s0[2], s1[2];
#pragma unroll
        for (int i = 0; i < 8; ++i) rsr[i] = rs0[row0 + (i >> 2) * HALF + (i & 3) * 16];
#pragma unroll
        for (int bj = 0; bj < 2; ++bj) { s0[bj] = *(const f32x4*)(sw + colb + bj * HALF); s1[bj] = *(const f32x4*)(sw + colb + bj * HALF + 4); }
#pragma unroll
        for (int ai = 0; ai < 2; ++ai) {
            f32x4 csv[4][2], snv[4][2];
            if (MODE == 2 && u.pn < 4) {
#pragma unroll
                for (int m = 0; m < 4; ++m)
#pragma unroll
                    for (int bj = 0; bj < 2; ++bj) { const int s = (row0 + ai * HALF + m * 16) & (SEQ - 1), i0 = ((colb + bj * HALF) & 127) >> 1; csv[m][bj] = *(const f32x4*)(rope + s * 64 + i0); snv[m][bj] = *(const f32x4*)(rope + SEQ * 64 + s * 64 + i0); }
            }
#pragma unroll
        for (int m = 0; m < 4; ++m) { const int row = row0 + ai * HALF + m * 16; const float rsv = rsr[ai * 4 + m];
#pragma unroll
        for (int bj = 0; bj < 2; ++bj) { const int col = colb + bj * HALF;
            f32x4 v0, v1;
#pragma unroll
            for (int j = 0; j < 4; ++j) { v0[j] = (float)acc[ai][bj][m][0][j] * (s0[bj][j] * rsv); v1[j] = (float)acc[ai][bj][m][1][j] * (s1[bj][j] * rsv); }
            if (MODE == 2) {
                if (u.pn < 4) {
                    const int head = 2 * (u.pn & 1) + bj;
                    const float lg = __builtin_log2f(1.0f - __builtin_amdgcn_exp2f(-5.0f - (float)head));
                    const float ii = (float)(row & 127);
                    const float fac = __builtin_amdgcn_exp2f((u.pn < 2 ? ii : -ii) * lg);
                    const f32x4 c4 = csv[m][bj], s4 = snv[m][bj];
                    f32x4 r0, r1;
                    r0[0] = (v0[0] * c4[0] - v0[1] * s4[0]) * fac; r0[1] = (v0[0] * s4[0] + v0[1] * c4[0]) * fac;
                    r0[2] = (v0[2] * c4[1] - v0[3] * s4[1]) * fac; r0[3] = (v0[2] * s4[1] + v0[3] * c4[1]) * fac;
                    r1[0] = (v1[0] * c4[2] - v1[1] * s4[2]) * fac; r1[1] = (v1[0] * s4[2] + v1[1] * c4[2]) * fac;
                    r1[2] = (v1[2] * c4[3] - v1[3] * s4[3]) * fac; r1[3] = (v1[2] * s4[3] + v1[3] * c4[3]) * fac;
                    v0 = r0; v1 = r1;
                } else if (u.pn >= 8) {
#pragma unroll
                    for (int j = 0; j < 4; ++j) { v0[j] = v0[j] * sigmoidf_(v0[j]); v1[j] = v1[j] * sigmoidf_(v1[j]); }
                }
            }
            *(u32x4*)(O + (size_t)row * ldc + col) = pack8(v0, v1);
        } } }
    }
};
struct EpiM1 {
    bf16_t* O; const bf16_t* gate;
    __device__ __forceinline__ void operator()(const f32x4 (&acc)[2][2][4][2], const Unit& u, int wr, int wc, int fr, int fq) const {
        const int row0 = u.pm * BM + wr * 64 + fr, colb = u.pn * BM + wc * 32 + 8 * fq;
#pragma unroll
        for (int ai = 0; ai < 2; ++ai) {
            u32x4 gw[4][2];
#pragma unroll
            for (int m = 0; m < 4; ++m)
#pragma unroll
                for (int bj = 0; bj < 2; ++bj) gw[m][bj] = *(const u32x4*)(gate + (size_t)(row0 + ai * HALF + m * 16) * N_GATE + colb + bj * HALF);
#pragma unroll
            for (int m = 0; m < 4; ++m)
#pragma unroll
                for (int bj = 0; bj < 2; ++bj) { const u32x4 g = gw[m][bj]; f32x4 v0 = acc[ai][bj][m][0], v1 = acc[ai][bj][m][1];
                    v0[0] *= sigmoidf_(bflo(g.x)); v0[1] *= sigmoidf_(bfhi(g.x)); v0[2] *= sigmoidf_(bflo(g.y)); v0[3] *= sigmoidf_(bfhi(g.y));
                    v1[0] *= sigmoidf_(bflo(g.z)); v1[1] *= sigmoidf_(bfhi(g.z)); v1[2] *= sigmoidf_(bflo(g.w)); v1[3] *= sigmoidf_(bfhi(g.w));
                    *(u32x4*)(O + (size_t)(row0 + ai * HALF + m * 16) * DM + colb + bj * HALF) = pack8(v0, v1); }
        }
    }
};
struct EpiMerge {
    bf16_t* O; const bf16_t* gate; const bf16_t* M1;
    __device__ __forceinline__ void operator()(const f32x4 (&acc)[2][2][4][2], const Unit& u, int wr, int wc, int fr, int fq) const {
        const int row0 = u.pm * BM + wr * 64 + fr, colb = u.pn * BM + wc * 32 + 8 * fq;
#pragma unroll
        for (int ai = 0; ai < 2; ++ai)
#pragma unroll
        for (int mh = 0; mh < 2; ++mh) {
            u32x4 gw[2][2], mw[2][2];
#pragma unroll
            for (int m2 = 0; m2 < 2; ++m2)
#pragma unroll
                for (int bj = 0; bj < 2; ++bj) { const size_t r = (size_t)(row0 + ai * HALF + (mh * 2 + m2) * 16); gw[m2][bj] = *(const u32x4*)(gate + r * N_GATE + 1024 + colb + bj * HALF); mw[m2][bj] = *(const u32x4*)(M1 + r * DM + colb + bj * HALF); }
#pragma unroll
            for (int m2 = 0; m2 < 2; ++m2)
#pragma unroll
                for (int bj = 0; bj < 2; ++bj) { const int m = mh * 2 + m2; const u32x4 g = gw[m2][bj], q = mw[m2][bj]; f32x4 v0 = acc[ai][bj][m][0], v1 = acc[ai][bj][m][1];
                    v0[0] = v0[0] * sigmoidf_(bflo(g.x)) + bflo(q.x); v0[1] = v0[1] * sigmoidf_(bfhi(g.x)) + bfhi(q.x); v0[2] = v0[2] * sigmoidf_(bflo(g.y)) + bflo(q.y); v0[3] = v0[3] * sigmoidf_(bfhi(g.y)) + bfhi(q.y);
                    v1[0] = v1[0] * sigmoidf_(bflo(g.z)) + bflo(q.z); v1[1] = v1[1] * sigmoidf_(bfhi(g.z)) + bfhi(q.z); v1[2] = v1[2] * sigmoidf_(bflo(g.w)) + bflo(q.w); v1[3] = v1[3] * sigmoidf_(bfhi(g.w)) + bfhi(q.w);
                    *(u32x4*)(O + (size_t)(row0 + ai * HALF + m * 16) * DM + colb + bj * HALF) = pack8(v0, v1); }
        }
    }
};
struct EpiX1 {
    const float* x; float* x1;
    __device__ __forceinline__ void operator()(const f32x4 (&acc)[2][2][4][2], const Unit& u, int wr, int wc, int fr, int fq) const {
        const int row0 = u.pm * BM + wr * 64 + fr, colb = u.pn * BM + wc * 32 + 8 * fq;
#pragma unroll
        for (int ai = 0; ai < 2; ++ai)
#pragma unroll
        for (int mh = 0; mh < 2; ++mh) {
            f32x4 xv[2][2][2];
#pragma unroll
            for (int m2 = 0; m2 < 2; ++m2)
#pragma unroll
                for (int bj = 0; bj < 2; ++bj) { const size_t o = (size_t)(row0 + ai * HALF + (mh * 2 + m2) * 16) * DM + colb + bj * HALF; xv[m2][bj][0] = *(const f32x4*)(x + o); xv[m2][bj][1] = *(const f32x4*)(x + o + 4); }
#pragma unroll
            for (int m2 = 0; m2 < 2; ++m2)
#pragma unroll
                for (int bj = 0; bj < 2; ++bj) { const int m = mh * 2 + m2; const size_t o = (size_t)(row0 + ai * HALF + m * 16) * DM + colb + bj * HALF;
                    *(f32x4*)(x1 + o) = acc[ai][bj][m][0] + xv[m2][bj][0]; *(f32x4*)(x1 + o + 4) = acc[ai][bj][m][1] + xv[m2][bj][1]; }
        }
    }
};
struct EpiSwiglu {
    bf16_t* act; const float* b1; const float* rs; const float* sw;
    __device__ __forceinline__ void operator()(const i32x4 (&acc)[2][2][4][2], const Unit& u, int wr, int wc, int fr, int fq) const {
        const int c0 = u.pn * 128 + wc * 32 + 8 * fq;
        const float* bg = b1 + (size_t)u.e * 2048 + c0; const float* bu = bg + 1024;
        const f32x4 bg0 = *(const f32x4*)bg, bg1 = *(const f32x4*)(bg + 4), bu0 = *(const f32x4*)bu, bu1 = *(const f32x4*)(bu + 4);
        const float* sg = sw + (size_t)u.e * 2048 + u.pn * 256 + wc * 32 + 8 * fq; const float* su = sg + 128;
        const f32x4 sg0 = *(const f32x4*)sg, sg1 = *(const f32x4*)(sg + 4), su0 = *(const f32x4*)su, su1 = *(const f32x4*)(su + 4);
        float rsr[8];
#pragma unroll
        for (int i = 0; i < 8; ++i) rsr[i] = rs[u.pm * BM + (i >> 2) * HALF + wr * 64 + (i & 3) * 16 + fr];
#pragma unroll
        for (int ai = 0; ai < 2; ++ai)
#pragma unroll
            for (int m = 0; m < 4; ++m) {
                const int row = u.pm * BM + ai * HALF + wr * 64 + m * 16 + fr;
                const float r = rsr[ai * 4 + m];
                f32x4 a0, a1;
#pragma unroll
                for (int j = 0; j < 4; ++j) {
                    float g = fminf((float)acc[ai][0][m][0][j] * (r * sg0[j]) + bg0[j], 7.0f), up = fminf(fmaxf((float)acc[ai][1][m][0][j] * (r * su0[j]) + bu0[j], -7.0f), 7.0f);
                    a0[j] = (up + 1.0f) * g * sigmoidf_(1.702f * g);
                    g = fminf((float)acc[ai][0][m][1][j] * (r * sg1[j]) + bg1[j], 7.0f); up = fminf(fmaxf((float)acc[ai][1][m][1][j] * (r * su1[j]) + bu1[j], -7.0f), 7.0f);
                    a1[j] = (up + 1.0f) * g * sigmoidf_(1.702f * g);
                }
                const float qs = 1.0f / ACT_STEP;
                int q[8];
#pragma unroll
                for (int j = 0; j < 4; ++j) { q[j] = __float2int_rn(fminf(fmaxf(a0[j] * qs, -127.0f), 127.0f)); q[4 + j] = __float2int_rn(fminf(fmaxf(a1[j] * qs, -127.0f), 127.0f)); }
                u32x2 ow; ow.x = (unsigned)(q[0] & 255) | ((unsigned)(q[1] & 255) << 8) | ((unsigned)(q[2] & 255) << 16) | ((unsigned)q[3] << 24);
                ow.y = (unsigned)(q[4] & 255) | ((unsigned)(q[5] & 255) << 8) | ((unsigned)(q[6] & 255) << 16) | ((unsigned)q[7] << 24);
                *(u32x2*)((signed char*)act + (size_t)row * DEXP + c0) = ow;
            }
    }
};
struct EpiDown {
    bf16_t* Y; const float* b2; const float* w; const float* sw;
    __device__ __forceinline__ void operator()(const i32x4 (&acc)[2][2][4][2], const Unit& u, int wr, int wc, int fr, int fq) const {
        const int row0 = u.pm * BM + wr * 64 + fr, colb = u.pn * BM + wc * 32 + 8 * fq;
        float wt[8]; f32x4 s0[2], s1[2], b0[2], b1v[2];
#pragma unroll
        for (int i = 0; i < 8; ++i) wt[i] = w[row0 + (i >> 2) * HALF + (i & 3) * 16];
#pragma unroll
        for (int bj = 0; bj < 2; ++bj) { const float* bb = b2 + (size_t)u.e * DM + colb + bj * HALF; const float* sp = sw + (size_t)u.e * DM + colb + bj * HALF;
            s0[bj] = *(const f32x4*)sp * ACT_STEP; s1[bj] = *(const f32x4*)(sp + 4) * ACT_STEP; b0[bj] = *(const f32x4*)bb; b1v[bj] = *(const f32x4*)(bb + 4); }
#pragma unroll
        for (int ai = 0; ai < 2; ++ai)
#pragma unroll
        for (int m = 0; m < 4; ++m) { const int row = row0 + ai * HALF + m * 16; const float wv = wt[ai * 4 + m];
#pragma unroll
        for (int bj = 0; bj < 2; ++bj) { const int col = colb + bj * HALF;
            f32x4 v0, v1;
#pragma unroll
            for (int j = 0; j < 4; ++j) { v0[j] = ((float)acc[ai][bj][m][0][j] * s0[bj][j] + b0[bj][j]) * wv; v1[j] = ((float)acc[ai][bj][m][1][j] * s1[bj][j] + b1v[bj][j]) * wv; }
            *(u32x4*)(Y + (size_t)row * DM + col) = pack8(v0, v1);
        } }
    }
};
}

__device__ const unsigned char T5B[3][129] = {
{0,1,2,3,4,5,6,7,8,9,10,11,12,13,14,15,16,16,16,16,16,16,17,17,17,17,17,17,17,17,18,18,18,18,18,18,18,18,18,18,19,19,19,19,19,19,19,19,19,19,19,19,19,19,20,20,20,20,20,20,20,20,20,20,20,20,20,20,20,20,20,20,20,21,21,21,21,21,21,21,21,21,21,21,21,21,21,21,21,21,21,21,21,21,21,21,21,21,21,22,22,22,22,22,22,22,22,22,22,22,22,22,22,22,22,22,22,22,22,22,22,22,22,22,22,22,22,22,22},
{0,4,8,12,16,16,17,17,18,18,19,19,19,19,20,20,20,20,20,21,21,21,21,21,21,22,22,22,22,22,22,22,22,22,23,23,23,23,23,23,23,23,23,23,23,23,24,24,24,24,24,24,24,24,24,24,24,24,24,24,24,24,25,25,25,25,25,25,25,25,25,25,25,25,25,25,25,25,25,25,25,25,25,26,26,26,26,26,26,26,26,26,26,26,26,26,26,26,26,26,26,26,26,26,26,26,26,26,26,26,26,26,26,27,27,27,27,27,27,27,27,27,27,27,27,27,27,27,27},
{0,16,18,19,20,21,21,22,22,23,23,23,24,24,24,24,25,25,25,25,25,26,26,26,26,26,26,26,26,27,27,27,27,27,27,27,27,27,27,28,28,28,28,28,28,28,28,28,28,28,28,28,29,29,29,29,29,29,29,29,29,29,29,29,29,29,29,29,29,29,30,30,30,30,30,30,30,30,30,30,30,30,30,30,30,30,30,30,30,30,30,30,30,30,30,31,31,31,31,31,31,31,31,31,31,31,31,31,31,31,31,31,31,31,31,31,31,31,31,31,31,31,31,31,31,31,31,31,31}};

struct Frame {
    LAS unsigned char* lds;
    int tid, lane, wave, G;
    unsigned char* ws; unsigned char* dout;
    const float* in[15];
};
struct Args { const float* in[15]; float* out; unsigned char* ws; int ph_lo, ph_hi;
 };

template <int CS_MODE  , int NMAP  >
__device__ __forceinline__ void p0_transpose_item(const float* W, int K, int N, int ld, bf16_t* WT, const float* rs, LAS float* scr, int item, int lane) {
    const int nblk = N / 64, kb = item / nblk, nb = item % nblk, k0 = 64 * kb, n0 = 64 * nb;
    const int lr = lane >> 4, lc = (lane & 15) * 4;
    f32x4 v[16];
#pragma unroll
    for (int i = 0; i < 16; ++i) v[i] = *(const f32x4*)(W + (size_t)(k0 + 4 * i + lr) * ld + n0 + lc);
#pragma unroll
    for (int i = 0; i < 16; ++i) {
        const int kk = 4 * i + lr; const float r = rs ? rs[k0 + kk] : 1.0f;
        scr[kk * 65 + lc + 0] = v[i][0] * r; scr[kk * 65 + lc + 1] = v[i][1] * r; scr[kk * 65 + lc + 2] = v[i][2] * r; scr[kk * 65 + lc + 3] = v[i][3] * r;
    }
    LDS_WAIT(); asm volatile("" ::: "memory");
    const int c = lane & 7;
#pragma unroll
    for (int j = 0; j < 8; ++j) {
        const int nl = (lane >> 3) + 8 * j, n = n0 + nl; const LAS float* sp = scr + (8 * c) * 65 + nl;
        float cs = 1.0f;
        if (CS_MODE == 2) { if (n >= 512 && n < 1024) cs = 0.08838834764831845f; }
        int nm = n;
        if (NMAP == 1) { nm = (n < 1024) ? (256 * (n >> 7) + (n & 127)) : (256 * ((n - 1024) >> 7) + 128 + ((n - 1024) & 127)); }
        u32x4 o; o.x = pk2(sp[0 * 65] * cs, sp[1 * 65] * cs); o.y = pk2(sp[2 * 65] * cs, sp[3 * 65] * cs); o.z = pk2(sp[4 * 65] * cs, sp[5 * 65] * cs); o.w = pk2(sp[6 * 65] * cs, sp[7 * 65] * cs);
        *(u32x4*)(WT + (size_t)nm * K + k0 + 8 * c) = o;
    }
    LDS_WAIT(); asm volatile("" ::: "memory");
}
struct QItem { int map, ld, n0; const float* W; const float* rs; signed char* Q; float* SW; };
#define P0_NMAP(MAP, n) ((MAP) == 1 ? (((n) < 1024) ? (256 * ((n) >> 7) + ((n) & 127)) : (256 * (((n) - 1024) >> 7) + 128 + (((n) - 1024) & 127))) : (n))
__device__ __forceinline__ void p0q_load(const Frame& F, const QItem& q, f32x4 (&v)[32], float (&rsv)[32]) {
    const int lr = F.lane >> 4, lc4 = F.lane & 15, w = F.wave;
    const unsigned voff = (unsigned)(((128 * w + 4 * lr) * q.ld + q.n0 + 4 * lc4) * 4);
    const float* rsl = q.rs + 128 * w + 4 * lr;
#pragma unroll
    for (int i = 0; i < 32; ++i) { const int kk = 16 * (i >> 2) + (i & 3); v[i] = *(const f32x4*)((const char*)q.W + (size_t)kk * q.ld * 4 + voff); rsv[i] = rsl[kk]; }
}
__device__ __forceinline__ void p0_quant_all(Frame& F, const float* w1, const float* w2, const float* w_in, const float* g_ffn, const float* g_mix) {
    LAS float* cm = (LAS float*)(F.lds + 8 * 16896);
    LAS unsigned* Tl = (LAS unsigned*)(F.lds + F.wave * 16896);
    const int lr = F.lane >> 4, lc4 = F.lane & 15, w = F.wave;
    constexpr int NIT = NEXP * 32 + 152 + NEXP * 16;
    auto item = [&](int it) { QItem q;
        if (it < NEXP * 32) { const int e = it >> 5; q.map = 1; q.W = w1 + (size_t)e * 1024 * 2048; q.ld = 2048; q.n0 = (it & 31) * 64; q.rs = g_ffn; q.Q = (signed char*)(F.ws + WS_W1) + (size_t)e * 2048 * 1024; q.SW = (float*)(F.ws + WS_SW1) + e * 2048; }
        else if (it < NEXP * 32 + 152) { q.map = 2; q.W = w_in; q.ld = PROJ_W; q.n0 = (it - NEXP * 32) * 64; q.rs = g_mix; q.Q = (signed char*)(F.ws + WS_WINQ); q.SW = (float*)(F.ws + WS_SWIN); }
        else { const int r2 = it - NEXP * 32 - 152, e = r2 >> 4; q.map = 0; q.W = w2 + (size_t)e * 1024 * 1024; q.ld = 1024; q.n0 = (r2 & 15) * 64; q.rs = nullptr; q.Q = (signed char*)(F.ws + WS_W2) + (size_t)e * 1024 * 1024; q.SW = (float*)(F.ws + WS_SW2) + e * 1024; }
        return q; };
    f32x4 v[32]; float rsv[32];
    int it = blockIdx.x;
    QItem q = item(it < NIT ? it : 0);
    if (q.rs == nullptr) q.rs = g_mix;
    if (it < NIT) p0q_load(F, q, v, rsv);
    while (it < NIT) {
        const int itn = it + F.G; const bool has = itn < NIT;
        QItem qn = item(has ? itn : it); if (qn.rs == nullptr) qn.rs = g_mix;
        const int MAP = q.map;
        f32x4 mx = {0.f, 0.f, 0.f, 0.f};
#pragma unroll
        for (int i = 0; i < 32; ++i) { if (MAP != 0) v[i] *= rsv[i]; mx[0] = fmaxf(mx[0], fabsf(v[i][0])); mx[1] = fmaxf(mx[1], fabsf(v[i][1])); mx[2] = fmaxf(mx[2], fabsf(v[i][2])); mx[3] = fmaxf(mx[3], fabsf(v[i][3])); }
#pragma unroll
        for (int c = 0; c < 4; ++c) { mx[c] = fmaxf(mx[c], __shfl_xor(mx[c], 16)); mx[c] = fmaxf(mx[c], __shfl_xor(mx[c], 32)); }
        __syncthreads();
        if (lr == 0) *(LAS f32x4*)(cm + w * 64 + 4 * lc4) = mx;
        __syncthreads();
#pragma unroll
        for (int ww = 0; ww < 8; ++ww) { const f32x4 o = *(const LAS f32x4*)(cm + ww * 64 + 4 * lc4); mx[0] = fmaxf(mx[0], o[0]); mx[1] = fmaxf(mx[1], o[1]); mx[2] = fmaxf(mx[2], o[2]); mx[3] = fmaxf(mx[3], o[3]); }
        f32x4 inv;
#pragma unroll
        for (int c = 0; c < 4; ++c) inv[c] = mx[c] > 0.f ? 127.0f / mx[c] : 0.f;
        if (w == 0 && lr == 0) {
#pragma unroll
            for (int c = 0; c < 4; ++c) { const int n = q.n0 + 4 * lc4 + c; float st = mx[c] * (1.0f / 127.0f); if (MAP == 2 && n < 1536) st *= 0.08838834764831845f * LOG2E; if (MAP == 2 && n >= 5120 && n < 5632) st *= 0.08838834764831845f; q.SW[P0_NMAP(MAP, n)] = st; }
        }
#pragma unroll
        for (int j = 0; j < 8; ++j)
#pragma unroll
            for (int c = 0; c < 4; ++c) {
                const int q0 = __float2int_rn(v[4 * j + 0][c] * inv[c]), q1 = __float2int_rn(v[4 * j + 1][c] * inv[c]), q2 = __float2int_rn(v[4 * j + 2][c] * inv[c]), q3 = __float2int_rn(v[4 * j + 3][c] * inv[c]);
                Tl[(4 * lc4 + c) * 33 + 4 * j + lr] = (unsigned)(q0 & 255) | ((unsigned)(q1 & 255) << 8) | ((unsigned)(q2 & 255) << 16) | ((unsigned)q3 << 24);
            }
        if (has) p0q_load(F, qn, v, rsv);
        LDS_WAIT(); asm volatile("" ::: "memory");
#pragma unroll
        for (int jj = 0; jj < 8; ++jj) {
            const int nl = (F.lane >> 3) + 8 * jj, ch = F.lane & 7, n = q.n0 + nl;
            u32x4 o; o.x = Tl[nl * 33 + 4 * ch + 0]; o.y = Tl[nl * 33 + 4 * ch + 1]; o.z = Tl[nl * 33 + 4 * ch + 2]; o.w = Tl[nl * 33 + 4 * ch + 3];
            *(u32x4*)(q.Q + (size_t)P0_NMAP(MAP, n) * 1024 + 128 * w + 16 * ch) = o;
        }
        LDS_WAIT(); asm volatile("" ::: "memory");
        q = qn; it = itn;
    }
    __syncthreads();
}
#undef P0_NMAP
__device__ __forceinline__ void p0_prologue(Frame& F) {
    LAS float* scr = (LAS float*)(F.lds + F.wave * 16896);
    const int gw = blockIdx.x * 8 + F.wave, NGW = F.G * 8;
    const float* x = F.in[0]; const float* g_mix = F.in[1]; const float* w_in = F.in[2]; const float* rel_bias = F.in[3];
    const float* w_att = F.in[4]; const float* w_ret = F.in[5]; const float* w_out = F.in[6]; const float* g_ffn = F.in[7];
    const float* w_router = F.in[8]; const float* w1 = F.in[10]; const float* w2 = F.in[12];
    constexpr int I_IN = 0, I_ATT = 8 * 16, I_RET = 16 * 16, I_OUT = 16 * 16, I_W1 = 16 * 32, I_W2 = 16 * 16;
    constexpr int NITEMS = I_IN + I_ATT + I_RET + I_OUT;
    for (int it = gw; it < NITEMS; it += NGW) {
        int r = it;
        if (r < I_ATT) { p0_transpose_item<0, 0>(w_att, 512, 1024, 1024, (bf16_t*)(F.ws + WS_WATT), nullptr, scr, r, F.lane); continue; } r -= I_ATT;
        if (r < I_RET) { p0_transpose_item<0, 0>(w_ret, 1024, 1024, 1024, (bf16_t*)(F.ws + WS_WRET), nullptr, scr, r, F.lane); continue; } r -= I_RET;
        p0_transpose_item<0, 0>(w_out, 1024, 1024, 1024, (bf16_t*)(F.ws + WS_WOUT), nullptr, scr, r, F.lane);
    }
    p0_quant_all(F, w1, w2, w_in, g_ffn, g_mix);
    unsigned* HBQ = (unsigned*)(F.dout + DO_HBQ); float* RS0 = (float*)(F.ws + WS_RS0);
    for (int m = 2 * gw; m < T_TOK; m += 2 * NGW) {
        const f32x4* xr = (const f32x4*)(x + (size_t)m * DM) + F.lane;
        f32x4 v[8]; float s0 = 0.f, s1 = 0.f;
#pragma unroll
        for (int j = 0; j < 8; ++j) v[j] = xr[64 * j];
#pragma unroll
        for (int j = 0; j < 4; ++j) { s0 += (v[j][0] * v[j][0] + v[j][1] * v[j][1]) + (v[j][2] * v[j][2] + v[j][3] * v[j][3]); s1 += (v[j + 4][0] * v[j + 4][0] + v[j + 4][1] * v[j + 4][1]) + (v[j + 4][2] * v[j + 4][2] + v[j + 4][3] * v[j + 4][3]); }
        const float r0 = 1.0f / sqrtf(wave_sum(s0) * (1.0f / DM) + NORM_EPS), r1 = 1.0f / sqrtf(wave_sum(s1) * (1.0f / DM) + NORM_EPS);
        float a0 = 0.f, a1 = 0.f;
#pragma unroll
        for (int j = 0; j < 4; ++j) { a0 = fmaxf(fmaxf(a0, fmaxf(fabsf(v[j][0]), fabsf(v[j][1]))), fmaxf(fabsf(v[j][2]), fabsf(v[j][3]))); a1 = fmaxf(fmaxf(a1, fmaxf(fabsf(v[j + 4][0]), fabsf(v[j + 4][1]))), fmaxf(fabsf(v[j + 4][2]), fabsf(v[j + 4][3]))); }
#pragma unroll
        for (int o = 1; o < 64; o <<= 1) { a0 = fmaxf(a0, __shfl_xor(a0, o)); a1 = fmaxf(a1, __shfl_xor(a1, o)); }
        const float q0i = a0 > 0.f ? 127.0f / a0 : 0.f, q1i = a1 > 0.f ? 127.0f / a1 : 0.f;
        if (F.lane == 0) { RS0[m] = r0 * a0 * (1.0f / 127.0f); RS0[m + 1] = r1 * a1 * (1.0f / 127.0f); }
        unsigned* oq = HBQ + (size_t)m * 256 + F.lane;
#pragma unroll
        for (int j = 0; j < 8; ++j) { const float qi = j < 4 ? q0i : q1i; const int b0 = __float2int_rn(v[j][0] * qi), b1 = __float2int_rn(v[j][1] * qi), b2 = __float2int_rn(v[j][2] * qi), b3 = __float2int_rn(v[j][3] * qi);
            oq[64 * j] = (unsigned)(b0 & 255) | ((unsigned)(b1 & 255) << 8) | ((unsigned)(b2 & 255) << 16) | ((unsigned)b3 << 24); }
    }
    const int gt = blockIdx.x * 512 + F.tid, NGT = F.G * 512;
    float* rope = (float*)(F.ws + WS_ROPE);
    for (int i = gt; i < SEQ * 64; i += NGT) {
        const int s = i >> 6, p = i & 63;
        const float inv = powf(10000.0f, -(float)(2 * p) / 128.0f);
        const float ang = (float)s * inv;
        float sn, cs; sincosf(ang, &sn, &cs);
        rope[i] = cs; rope[SEQ * 64 + i] = sn;
    }
    float* biasT = (float*)(F.ws + WS_BIAS);
    for (int i = gt; i < 12 * 132; i += NGT) {
        const int gh = i / 132, j = i % 132, g = gh >> 2;
        biasT[i] = (j <= 128) ? rel_bias[(int)T5B[g][j] * 12 + gh] * LOG2E : 0.0f;
    }
    float* wrl = (float*)(F.ws + WS_WRL);
    for (int i = gt; i < 1024 * 32; i += NGT) {
        const int c = i & 3, e = (i >> 2) & 31, g = (i >> 7) & 3, ii = i >> 9, k = 16 * ii + 4 * g + c;
        wrl[i] = g_ffn[k] * w_router[k * 32 + e];
    }
}

__device__ __forceinline__ void attn_phase(Frame& F, int g) {
    const int lg = (g == 0) ? 0 : (g == 1 ? 2 : 4), d = 1 << lg, nblk = (SEQ >> lg) >> 7;
    const bf16_t* AB = (const bf16_t*)(F.ws + DY_ATTBUF);
    bf16_t* ATT = (bf16_t*)(F.ws + DY_ATT);
    float* LSE = (float*)(F.ws + WS_LSE);
    const float* biasT = (const float*)(F.ws + WS_BIAS);
    LAS unsigned char* Kl = F.lds; LAS unsigned char* Vl = F.lds + 65536;
    LAS float* biasL = (LAS float*)(F.lds + LDS_AUX);
    const int lane = F.lane, w = F.wave, g4 = lane >> 4, l15 = lane & 15, q4 = l15 >> 2, p4 = lane & 3;
    u32x4 kreg[8], vreg[8]; bf16x8 qnx[4];
#define ATT_DECODE(it_, blk_, r_, slot_, b_) const int blk_ = (it_) % nblk, r_ = ((it_) / nblk) % d, slot_ = ((it_) / (nblk * d)) & 3, b_ = (it_) / (nblk * d * 4)
#define ATT_PREFETCH(it_) do { ATT_DECODE(it_, pblk, pr, pslot, pb); const int pm0 = pblk * 128, phead = 4 * g + pslot; \
        _Pragma("unroll") for (int j = 0; j < 8; ++j) { const int cidx = F.tid + 512 * j, kr = cidx >> 4, ch = cidx & 15; int step = pm0 - 128 + kr; step = step < 0 ? 0 : step; \
            const size_t rowoff = ((size_t)pb * SEQ + (size_t)step * d + pr) * N_ATT + phead * 128 + ch * 8; kreg[j] = *(const u32x4*)(AB + rowoff + 1536); vreg[j] = *(const u32x4*)(AB + rowoff + 3072); } \
        const size_t pq = (size_t)pb * SEQ + (size_t)(pm0 + 16 * w + l15) * d + pr; \
        _Pragma("unroll") for (int s = 0; s < 4; ++s) qnx[s] = *(const bf16x8*)(AB + pq * N_ATT + phead * 128 + 32 * s + 8 * g4); } while (0)
    if ((int)blockIdx.x < 2048) ATT_PREFETCH((int)blockIdx.x);
    for (int item = blockIdx.x; item < 2048; item += F.G) {
        ATT_DECODE(item, blk, r, slot, b);
        const int m0 = blk * 128, head = 4 * g + slot;
        __syncthreads();
        if (F.tid < 132) biasL[F.tid] = biasT[head * 132 + F.tid];
#pragma unroll
        for (int j = 0; j < 8; ++j) { const int cidx = F.tid + 512 * j, kr = cidx >> 4, ch = cidx & 15; *(LAS u32x4*)(Kl + off_b(kr, ch)) = kreg[j]; *(LAS u32x4*)(Vl + off_b(kr, ch)) = vreg[j]; }
        const int qstep = m0 + 16 * w + l15;
        const size_t qrow = (size_t)b * SEQ + (size_t)qstep * d + r;
        bf16x8 qf[4];
#pragma unroll
        for (int s = 0; s < 4; ++s) qf[s] = qnx[s];
        if (item + F.G < 2048) ATT_PREFETCH(item + F.G);
        __syncthreads();
        f32x4 sacc[9];
#pragma unroll
        for (int tt = 0; tt < 9; ++tt) {
            sacc[tt] = (f32x4){0.f, 0.f, 0.f, 0.f};
#pragma unroll
            for (int s = 0; s < 4; ++s) {
                const bf16x8 kf = *(const LAS bf16x8*)(Kl + off_b(16 * (w + tt) + l15, 4 * s + g4));
                sacc[tt] = __builtin_amdgcn_mfma_f32_16x16x32_bf16(kf, qf[s], sacc[tt], 0, 0, 0);
            }
        }
        const int kmin = 128 - m0;
        float mx = -1e30f;
#pragma unroll
        for (int tt = 0; tt < 9; ++tt)
#pragma unroll
            for (int rg = 0; rg < 4; ++rg) {
                const int dist = 128 + l15 - 16 * tt - 4 * g4 - rg, kidx = 16 * (w + tt) + 4 * g4 + rg;
                const bool valid = (dist >= 0) && (dist <= 128) && (kidx >= kmin);
                const int dc = dist < 0 ? 0 : (dist > 128 ? 128 : dist);
                const float v = valid ? sacc[tt][rg] + biasL[dc] : -1e30f;
                sacc[tt][rg] = v; mx = fmaxf(mx, v);
            }
        mx = fmaxf(mx, __shfl_xor(mx, 16)); mx = fmaxf(mx, __shfl_xor(mx, 32));
        float lsum = 0.f;
#pragma unroll
        for (int tt = 0; tt < 9; ++tt)
#pragma unroll
            for (int rg = 0; rg < 4; ++rg) { const float p = (sacc[tt][rg] > -1e29f) ? fast_exp2(sacc[tt][rg] - mx) : 0.f; sacc[tt][rg] = p; lsum += p; }
        lsum += __shfl_xor(lsum, 16); lsum += __shfl_xor(lsum, 32);
        f32x4 oacc[8];
#pragma unroll
        for (int dt = 0; dt < 8; ++dt) oacc[dt] = (f32x4){0.f, 0.f, 0.f, 0.f};
#pragma unroll
        for (int uu = 0; uu < 5; ++uu) {
            u32x4 pw; pw.x = pk2(sacc[2 * uu][0], sacc[2 * uu][1]); pw.y = pk2(sacc[2 * uu][2], sacc[2 * uu][3]);
            if (uu < 4) { pw.z = pk2(sacc[2 * uu + 1][0], sacc[2 * uu + 1][1]); pw.w = pk2(sacc[2 * uu + 1][2], sacc[2 * uu + 1][3]); } else { pw.z = 0u; pw.w = 0u; }
            const bf16x8 pf = __builtin_bit_cast(bf16x8, pw);
            const int r0 = 16 * (w + 2 * uu) + 4 * g4 + q4, r1 = (uu < 4) ? r0 + 16 : r0;
#pragma unroll
            for (int dt = 0; dt < 8; ++dt) {
                const s16x4 lo = tr_read(Vl + off_b(r0, 2 * dt + (p4 >> 1)) + 8 * (p4 & 1));
                const s16x4 hi = tr_read(Vl + off_b(r1, 2 * dt + (p4 >> 1)) + 8 * (p4 & 1));
                oacc[dt] = __builtin_amdgcn_mfma_f32_16x16x32_bf16(cat8(lo, hi), pf, oacc[dt], 0, 0, 0);
            }
        }
        const float rl = 1.0f / lsum;
        float lse = mx + __builtin_log2f(lsum);
        float wn = 1.0f, wp = 0.0f;
        bf16_t* orow = ATT + qrow * 512 + slot * 128 + 4 * g4;
        if (g > 0) {
            const float lp = LSE[qrow * 4 + slot];
            const float M = fmaxf(lp, lse); const float en = fast_exp2(lse - M), ep = fast_exp2(lp - M), tot = en + ep;
            wn = en / tot; wp = ep / tot; lse = M + __builtin_log2f(tot);
        }
        u32x2 pvv[8];
        if (g > 0) {
#pragma unroll
            for (int dt = 0; dt < 8; ++dt) pvv[dt] = *(const u32x2*)(orow + 16 * dt);
        }
#pragma unroll
        for (int dt = 0; dt < 8; ++dt) {
            f32x4 o = oacc[dt] * (rl * wn);
            if (g > 0) { const u32x2 pv = pvv[dt]; o[0] += wp * bflo(pv.x); o[1] += wp * bfhi(pv.x); o[2] += wp * bflo(pv.y); o[3] += wp * bfhi(pv.y); }
            u32x2 ow; ow.x = pk2(o[0], o[1]); ow.y = pk2(o[2], o[3]);
            *(u32x2*)(orow + 16 * dt) = ow;
        }
        if (g4 == 0) LSE[qrow * 4 + slot] = lse;
    }
#undef ATT_DECODE
#undef ATT_PREFETCH
}

__device__ __forceinline__ float ret_log2g(int h) { return __builtin_log2f(1.0f - __builtin_amdgcn_exp2f(-5.0f - (float)h)); }
__device__ __forceinline__ void ret_state_phase(Frame& F) {
    const bf16_t* RB = (const bf16_t*)(F.ws + DY_RETBUF);
    bf16_t* SR = (bf16_t*)(F.dout + DO_SR);
    const int lane = F.lane, w = F.wave, g4 = lane >> 4, l15 = lane & 15, q4 = l15 >> 2, p4 = lane & 3;
    for (int item = blockIdx.x; item < 256; item += F.G) {
        const int es = item & 3, h = (item >> 2) & 3, b = item >> 4;
        const float g128 = __builtin_amdgcn_exp2f(128.0f * ret_log2g(h));
        f32x4 acc[4];
#pragma unroll
        for (int et = 0; et < 4; ++et) acc[et] = (f32x4){0.f, 0.f, 0.f, 0.f};
        u32x4 kreg[4], vreg[2];
        const size_t rowbase = (size_t)b * SEQ;
#define RS_LOAD(n) do { \
            _Pragma("unroll") for (int j = 0; j < 4; ++j) { const int cidx = F.tid + 512 * j, jr = cidx >> 4, ch = cidx & 15; kreg[j] = *(const u32x4*)(RB + (rowbase + (n) * 128 + jr) * N_RET + 512 + h * 128 + ch * 8); } \
            _Pragma("unroll") for (int j = 0; j < 2; ++j) { const int cidx = F.tid + 512 * j, jr = cidx >> 3, ch = cidx & 7; vreg[j] = *(const u32x4*)(RB + (rowbase + (n) * 128 + jr) * N_RET + 1024 + h * 256 + es * 64 + ch * 8); } } while (0)
#define RS_STORE(buf) do { \
            _Pragma("unroll") for (int j = 0; j < 4; ++j) { const int cidx = F.tid + 512 * j, jr = cidx >> 4, ch = cidx & 15; *(LAS u32x4*)(F.lds + (buf) * 65536 + off_b(jr, ch)) = kreg[j]; } \
            _Pragma("unroll") for (int j = 0; j < 2; ++j) { const int cidx = F.tid + 512 * j, jr = cidx >> 3, ch = cidx & 7; *(LAS u32x4*)(F.lds + (buf) * 65536 + 32768 + off_b(jr, ch)) = vreg[j]; } } while (0)
        __syncthreads();
        RS_LOAD(0); RS_STORE(0);
        __syncthreads();
        for (int n = 0; n < 32; ++n) {
            const int buf = n & 1;
            if (n + 1 < 32) RS_LOAD(n + 1);
            bf16_t* srow = SR + ((size_t)((b * 4 + h) * 32 + n) * 256 + es * 64 + l15) * 128 + 16 * w + 4 * g4;
#pragma unroll
            for (int et = 0; et < 4; ++et) { u32x2 ow; ow.x = pk2(acc[et][0], acc[et][1]); ow.y = pk2(acc[et][2], acc[et][3]); *(u32x2*)(srow + (size_t)et * 16 * 128) = ow; }
            const LAS unsigned char* Kb = F.lds + buf * 65536; const LAS unsigned char* Vb = Kb + 32768;
#pragma unroll
            for (int ks = 0; ks < 4; ++ks) {
                const int j0 = 32 * ks + 8 * g4 + q4;
                const s16x4 klo = tr_read(Kb + off_b(j0, 2 * w + (p4 >> 1)) + 8 * (p4 & 1));
                const s16x4 khi = tr_read(Kb + off_b(j0 + 4, 2 * w + (p4 >> 1)) + 8 * (p4 & 1));
                const bf16x8 kf = cat8(klo, khi);
#pragma unroll
                for (int et = 0; et < 4; ++et) {
                    const s16x4 vlo = tr_read(Vb + off_b(j0, 2 * et + (p4 >> 1)) + 8 * (p4 & 1));
                    const s16x4 vhi = tr_read(Vb + off_b(j0 + 4, 2 * et + (p4 >> 1)) + 8 * (p4 & 1));
                    acc[et] = __builtin_amdgcn_mfma_f32_16x16x32_bf16(kf, cat8(vlo, vhi), acc[et], 0, 0, 0);
                }
            }
#pragma unroll
            for (int et = 0; et < 4; ++et) acc[et] *= g128;
            if (n + 1 < 32) RS_STORE(buf ^ 1);
            __syncthreads();
        }
#undef RS_LOAD
#undef RS_STORE
    }
}
__device__ __forceinline__ void ret_out_phase(Frame& F) {
    const bf16_t* RB = (const bf16_t*)(F.ws + DY_RETBUF);
    const bf16_t* SR = (const bf16_t*)(F.dout + DO_SR);
    bf16_t* RETN = (bf16_t*)(F.dout + DO_RETN);
    const int lane = F.lane, w = F.wave, g4 = lane >> 4, l15 = lane & 15, q4 = l15 >> 2, p4 = lane & 3;
    LAS unsigned char* Vl = F.lds;
    LAS unsigned char* Rl = F.lds + 65536;
    for (int item = blockIdx.x; item < 2048; item += F.G) {
        const int n = item & 31, h = (item >> 5) & 3, b = item >> 7;
        const size_t rowbase = (size_t)b * SEQ + n * 128;
        __syncthreads();
#pragma unroll
        for (int j = 0; j < 8; ++j) {
            const int cidx = F.tid + 512 * j;
            { const int jr = cidx >> 5, ch = cidx & 31; const u32x4 v = *(const u32x4*)(RB + (rowbase + jr) * N_RET + 1024 + h * 256 + ch * 8);
              *(LAS u32x4*)(Vl + (ch >> 4) * 32768 + off_b(jr, ch & 15)) = v; }
            { const int er = cidx >> 4, ch = cidx & 15; const u32x4 v = *(const u32x4*)(SR + ((size_t)((b * 4 + h) * 32 + n) * 256 + er) * 128 + ch * 8);
              *(LAS u32x4*)(Rl + off_b(er, ch)) = v; }
        }
        const size_t qrow = rowbase + 16 * w + l15;
        bf16x8 qf[4];
#pragma unroll
        for (int s = 0; s < 4; ++s) qf[s] = *(const bf16x8*)(RB + qrow * N_RET + h * 128 + 32 * s + 8 * g4);
        f32x4 sacc[8];
#pragma unroll
        for (int hb = 0; hb < 2; ++hb) {
            bf16x8 kf[4][4];
#pragma unroll
            for (int t4 = 0; t4 < 4; ++t4) { const int tt = 4 * hb + t4, tc = tt <= w ? tt : w;
#pragma unroll
                for (int s = 0; s < 4; ++s) kf[t4][s] = *(const bf16x8*)(RB + (rowbase + 16 * tc + l15) * N_RET + 512 + h * 128 + 32 * s + 8 * g4); }
#pragma unroll
            for (int t4 = 0; t4 < 4; ++t4) { const int tt = 4 * hb + t4;
                f32x4 a = (f32x4){0.f, 0.f, 0.f, 0.f};
#pragma unroll
                for (int s = 0; s < 4; ++s) a = __builtin_amdgcn_mfma_f32_16x16x32_bf16(kf[t4][s], qf[s], a, 0, 0, 0);
                if (tt > w) a = (f32x4){0.f, 0.f, 0.f, 0.f};
                if (tt == w) {
#pragma unroll
                    for (int rg = 0; rg < 4; ++rg) if (4 * g4 + rg > l15) a[rg] = 0.f;
                }
                sacc[tt] = a;
            }
        }
        __syncthreads();
        f32x4 oacc[16];
#pragma unroll
        for (int et = 0; et < 16; ++et) oacc[et] = (f32x4){0.f, 0.f, 0.f, 0.f};
#pragma unroll
        for (int uu = 0; uu < 4; ++uu) {
            if (2 * uu <= w) {
                u32x4 pw; pw.x = pk2(sacc[2 * uu][0], sacc[2 * uu][1]); pw.y = pk2(sacc[2 * uu][2], sacc[2 * uu][3]);
                pw.z = pk2(sacc[2 * uu + 1][0], sacc[2 * uu + 1][1]); pw.w = pk2(sacc[2 * uu + 1][2], sacc[2 * uu + 1][3]);
                const bf16x8 pf = __builtin_bit_cast(bf16x8, pw);
                const int r0 = 32 * uu + 4 * g4 + q4, r1 = r0 + 16;
#pragma unroll
                for (int et = 0; et < 16; ++et) {
                    const LAS unsigned char* vb = Vl + (et >> 3) * 32768;
                    const s16x4 lo = tr_read(vb + off_b(r0, 2 * (et & 7) + (p4 >> 1)) + 8 * (p4 & 1));
                    const s16x4 hi = tr_read(vb + off_b(r1, 2 * (et & 7) + (p4 >> 1)) + 8 * (p4 & 1));
                    oacc[et] = __builtin_amdgcn_mfma_f32_16x16x32_bf16(cat8(lo, hi), pf, oacc[et], 0, 0, 0);
                }
            }
        }
#pragma unroll
        for (int et = 0; et < 16; ++et)
#pragma unroll
            for (int s = 0; s < 4; ++s) {
                const bf16x8 rf = *(const LAS bf16x8*)(Rl + off_b(16 * et + l15, 4 * s + g4));
                oacc[et] = __builtin_amdgcn_mfma_f32_16x16x32_bf16(rf, qf[s], oacc[et], 0, 0, 0);
            }
        float sm = 0.f;
#pragma unroll
        for (int et = 0; et < 16; ++et) sm += (oacc[et][0] + oacc[et][1]) + (oacc[et][2] + oacc[et][3]);
        sm += __shfl_xor(sm, 16); sm += __shfl_xor(sm, 32);
        const float mean = sm * (1.0f / 256.0f);
        float sq = 0.f;
#pragma unroll
        for (int et = 0; et < 16; ++et) { const f32x4 dv = oacc[et] - mean; sq += (dv[0] * dv[0] + dv[1] * dv[1]) + (dv[2] * dv[2] + dv[3] * dv[3]); }
        sq += __shfl_xor(sq, 16); sq += __shfl_xor(sq, 32);
        const float rstd = 1.0f / sqrtf(sq * (1.0f / 256.0f) + NORM_EPS);
        const bf16_t* grow = RB + qrow * N_RET + 2048 + h * 256 + 4 * g4;
        bf16_t* orow = RETN + qrow * 1024 + h * 256 + 4 * g4;
        u32x2 gwv[16];
#pragma unroll
        for (int et = 0; et < 16; ++et) gwv[et] = *(const u32x2*)(grow + 16 * et);
#pragma unroll
        for (int et = 0; et < 16; ++et) {
            const u32x2 gw = gwv[et];
            const f32x4 y = (oacc[et] - mean) * rstd;
            u32x2 ow; ow.x = pk2(y[0] * bflo(gw.x), y[1] * bfhi(gw.x)); ow.y = pk2(y[2] * bflo(gw.y), y[3] * bfhi(gw.y));
            *(u32x2*)(orow + 16 * et) = ow;
        }
    }
}

__device__ __forceinline__ void router_phase(Frame& F) {
    const float* X1 = (const float*)F.dout;
    const float* wrl = (const float*)(F.ws + WS_WRL);
    const float* b_router = F.in[9];
    float* RSTD = (float*)(F.ws + WS_RSTD);
    unsigned* X1Q = (unsigned*)(F.ws + DY_X1B);
    int* asg_e = (int*)(F.ws + WS_ASG); float* asg_w = (float*)(F.ws + WS_ASG + 1 * MiB); int* asg_idx = (int*)(F.ws + WS_ASG + 2 * MiB);
    unsigned* gcnt = (unsigned*)(F.ws + WS_CTL) + CW_GCNT;
    LAS f32x4* WL = (LAS f32x4*)F.lds;
    LAS unsigned* hist = (LAS unsigned*)(F.lds + LDS_AUX);
    LAS unsigned* basel = hist + 32;
    LAS unsigned char* lds_e = (LAS unsigned char*)(F.lds + LDS_AUX + 256);
    LAS unsigned short* lds_rank = (LAS unsigned short*)(F.lds + LDS_AUX + 1280);
    const int lane = F.lane, w = F.wave, g4 = lane >> 4, l15 = lane & 15;
    __syncthreads();
    for (int i = F.tid; i < 8192; i += 512) WL[i] = ((const f32x4*)wrl)[i];
    if (F.tid < 32) hist[F.tid] = 0u;
    __syncthreads();
    for (int tb = blockIdx.x; tb < 256; tb += F.G) {
        const int half = tb >> 8;
#pragma unroll 1
        for (int it = 0; it < 2; ++it) {
            const int rg = 2 * w + it, row0 = tb * 256 + rg * 16;
            const float* xr = X1 + (size_t)(row0 + l15) * DM + 4 * g4;
            f32x4 acc0 = {0.f, 0.f, 0.f, 0.f}, acc1 = {0.f, 0.f, 0.f, 0.f}; float ss = 0.f, amax = 0.f;
#pragma unroll 1
            for (int ib = 0; ib < 8; ++ib) {
                f32x4 xv[8];
#pragma unroll
                for (int ii = 0; ii < 8; ++ii) xv[ii] = *(const f32x4*)(xr + 16 * (8 * ib + ii));
#pragma unroll
                for (int ii = 0; ii < 8; ++ii) {
                    const int i = 8 * ib + ii;
                    const f32x4 w0 = WL[(i * 4 + g4) * 32 + l15], w1 = WL[(i * 4 + g4) * 32 + 16 + l15];
#pragma unroll
                    for (int c = 0; c < 4; ++c) {
                        ss += xv[ii][c] * xv[ii][c]; amax = fmaxf(amax, fabsf(xv[ii][c]));
                        acc0 = __builtin_amdgcn_mfma_f32_16x16x4f32(xv[ii][c], w0[c], acc0, 0, 0, 0);
                        acc1 = __builtin_amdgcn_mfma_f32_16x16x4f32(xv[ii][c], w1[c], acc1, 0, 0, 0);
                    }
                }
            }
            ss += __shfl_xor(ss, 16); ss += __shfl_xor(ss, 32);
            const float rs = 1.0f / sqrtf(ss * (1.0f / DM) + NORM_EPS);
            amax = fmaxf(amax, __shfl_xor(amax, 16)); amax = fmaxf(amax, __shfl_xor(amax, 32));
            const float qinv = amax > 0.f ? 127.0f / amax : 0.f;
            if (lane < 16) RSTD[row0 + lane] = rs * amax * (1.0f / 127.0f);
#pragma unroll 1
            for (int ib = 0; ib < 8; ++ib) {
                f32x4 xq[8];
#pragma unroll
                for (int ii = 0; ii < 8; ++ii) xq[ii] = *(const f32x4*)(xr + 16 * (8 * ib + ii));
#pragma unroll
                for (int ii = 0; ii < 8; ++ii) {
                    const int q0 = __float2int_rn(xq[ii][0] * qinv), q1 = __float2int_rn(xq[ii][1] * qinv), q2 = __float2int_rn(xq[ii][2] * qinv), q3 = __float2int_rn(xq[ii][3] * qinv);
                    X1Q[(size_t)(row0 + l15) * 256 + 4 * (8 * ib + ii) + g4] = (unsigned)(q0 & 255) | ((unsigned)(q1 & 255) << 8) | ((unsigned)(q2 & 255) << 16) | ((unsigned)q3 << 24);
                }
            }
            const float b0 = b_router[l15], b1 = b_router[16 + l15];
#pragma unroll
            for (int rgi = 0; rgi < 4; ++rgi) {
                const float rr = __shfl(rs, 4 * g4 + rgi);
                float v0 = acc0[rgi] * rr + b0, v1 = acc1[rgi] * rr + b1;
                float pv[4]; int pi[4];
#pragma unroll
                for (int pk = 0; pk < 4; ++pk) {
                    float bv; int bi;
                    if (v0 >= v1) { bv = v0; bi = l15; } else { bv = v1; bi = 16 + l15; }
#pragma unroll
                    for (int o = 1; o < 16; o <<= 1) {
                        const float ov = __shfl_xor(bv, o); const int oi = __shfl_xor(bi, o);
                        if (ov > bv || (ov == bv && oi < bi)) { bv = ov; bi = oi; }
                    }
                    pv[pk] = bv; pi[pk] = bi;
                    if (bi == l15) v0 = -3.0e38f;
                    if (bi == 16 + l15) v1 = -3.0e38f;
                }
                if (l15 == 0) {
                    const float e1 = __expf(pv[1] - pv[0]), e2 = __expf(pv[2] - pv[0]), e3 = __expf(pv[3] - pv[0]);
                    const float inv = 1.0f / (1.0f + e1 + e2 + e3);
                    const float gt[4] = {inv, e1 * inv, e2 * inv, e3 * inv};
                    const int tl = rg * 16 + 4 * g4 + rgi, tok = tb * 256 + tl;
#pragma unroll
                    for (int pk = 0; pk < 4; ++pk) {
                        const unsigned rk = atomicAdd((unsigned*)&hist[pi[pk]], 1u);
                        lds_e[tl * 4 + pk] = (unsigned char)pi[pk]; lds_rank[tl * 4 + pk] = (unsigned short)rk;
                        asg_w[tok * 4 + pk] = gt[pk];
                    }
                }
            }
        }
        __syncthreads();
        if (F.tid < 32) { basel[F.tid] = atomicAdd(&gcnt[half * 32 + F.tid], hist[F.tid]); }
        __syncthreads();
        for (int a = F.tid; a < 1024; a += 512) {
            const int e = lds_e[a];
            asg_e[tb * 1024 + a] = e; asg_idx[tb * 1024 + a] = (int)(basel[e] + lds_rank[a]);
        }
        __syncthreads();
        if (F.tid < 32) hist[F.tid] = 0u;
        __syncthreads();
    }
}
__device__ __forceinline__ void scatter_phase(Frame& F) {
    const unsigned* gcnt = (const unsigned*)(F.ws + WS_CTL) + CW_GCNT;
    const float* RSTD = (const float*)(F.ws + WS_RSTD);
    const int* asg_e = (const int*)(F.ws + WS_ASG); const float* asg_w = (const float*)(F.ws + WS_ASG + 1 * MiB); const int* asg_idx = (const int*)(F.ws + WS_ASG + 2 * MiB);
    int* asg_pos = (int*)(F.ws + WS_ASG + 3 * MiB);
    int* tile_expert = (int*)(F.ws + WS_TILE);
    LAS int* seg = (LAS int*)(F.lds + LDS_AUX);
    LAS int* cntl = seg + 64;
    __syncthreads();
    if (F.tid < 2) {
        int run = 0;
        for (int e = 0; e < 32; ++e) { const int c = (int)__hip_atomic_load(&gcnt[F.tid * 32 + e], __ATOMIC_RELAXED, __HIP_MEMORY_SCOPE_AGENT); seg[F.tid * 32 + e] = run; cntl[F.tid * 32 + e] = c; run += (c + 255) & ~255; }
        if (blockIdx.x == 0) tile_expert[2 * HALF_TILES + F.tid] = run >> 8;
    }
    __syncthreads();
    const int gt = blockIdx.x * 512 + F.tid, NGT = F.G * 512;
    for (int a = gt; a < T_TOK * 4; a += NGT) {
        const int tok = a >> 2, half = tok >> 16, e = asg_e[a];
        const int pos = seg[half * 32 + e] + asg_idx[a];
        int* tokS = (int*)(F.ws + WS_SORT + (size_t)half * 3 * HALF_ROWS * 4); float* wS = (float*)(tokS + HALF_ROWS); float* rS = wS + HALF_ROWS;
        tokS[pos] = tok; wS[pos] = asg_w[a]; rS[pos] = RSTD[tok]; asg_pos[a] = pos;
    }
    for (int j = blockIdx.x; j < 32; j += F.G) {
        const int half = j >> 5, e = j & 31, s0 = seg[j], c = cntl[j], pe = (c + 255) & ~255;
        int* tokS = (int*)(F.ws + WS_SORT + (size_t)half * 3 * HALF_ROWS * 4); float* wS = (float*)(tokS + HALF_ROWS); float* rS = wS + HALF_ROWS;
        for (int i = c + F.tid; i < pe; i += 512) { tokS[s0 + i] = half * HALF_TOK; wS[s0 + i] = 0.f; rS[s0 + i] = 0.f; }
        for (int t = F.tid; t < (pe >> 8); t += 512) tile_expert[half * HALF_TILES + (s0 >> 8) + t] = e;
    }
}
__device__ __forceinline__ void final_phase(Frame& F, int half) {
    float* X1 = (float*)F.dout;
    const bf16_t* Y = (const bf16_t*)(F.ws + DY_Y);
    const int* asg_pos = (const int*)(F.ws + WS_ASG + 3 * MiB);
    const float* gfin = F.in[14];
    const int gw = blockIdx.x * 8 + F.wave, NGW = F.G * 8;
    for (int m0 = half * HALF_TOK + 2 * gw; m0 < (half + 1) * HALF_TOK; m0 += 2 * NGW) {
        int pos[2][4]; f32x4 v[2][4]; u32x2 yw[2][4][4];
#pragma unroll
        for (int r = 0; r < 2; ++r)
#pragma unroll
            for (int k = 0; k < 4; ++k) pos[r][k] = asg_pos[(m0 + r) * 4 + k];
#pragma unroll
        for (int r = 0; r < 2; ++r)
#pragma unroll
            for (int j = 0; j < 4; ++j) {
                v[r][j] = ((const f32x4*)(X1 + (size_t)(m0 + r) * DM) + F.lane)[64 * j];
#pragma unroll
                for (int k = 0; k < 4; ++k) yw[r][j][k] = *((const u32x2*)(Y + (size_t)pos[r][k] * DM) + F.lane + 64 * j);
            }
        float s[2] = {0.f, 0.f};
#pragma unroll
        for (int r = 0; r < 2; ++r)
#pragma unroll
            for (int j = 0; j < 4; ++j) {
#pragma unroll
                for (int k = 0; k < 4; ++k) { v[r][j][0] += bflo(yw[r][j][k].x); v[r][j][1] += bfhi(yw[r][j][k].x); v[r][j][2] += bflo(yw[r][j][k].y); v[r][j][3] += bfhi(yw[r][j][k].y); }
                s[r] += (v[r][j][0] * v[r][j][0] + v[r][j][1] * v[r][j][1]) + (v[r][j][2] * v[r][j][2] + v[r][j][3] * v[r][j][3]);
            }
#pragma unroll
        for (int r = 0; r < 2; ++r) {
            const float rstd = 1.0f / sqrtf(wave_sum(s[r]) * (1.0f / DM) + NORM_EPS);
            f32x4* xr = (f32x4*)(X1 + (size_t)(m0 + r) * DM) + F.lane;
#pragma unroll
            for (int j = 0; j < 4; ++j) { const f32x4 gg = *((const f32x4*)gfin + F.lane + 64 * j); xr[64 * j] = v[r][j] * rstd * gg; }
        }
    }
}

constexpr int N_PHASES = 15;
__global__ void __launch_bounds__(512, 2) mk_fwd(Args args) {
    extern __shared__ __attribute__((aligned(16))) unsigned char lds_raw[];
    Frame F;
    F.lds = (LAS unsigned char*)lds_raw;
    F.tid = threadIdx.x; F.lane = F.tid & 63; F.wave = __builtin_amdgcn_readfirstlane(F.tid >> 6); F.G = gridDim.x;
    F.ws = args.ws; F.dout = (unsigned char*)args.out;
#pragma unroll
    for (int i = 0; i < 15; ++i) F.in[i] = args.in[i];
    volatile LAS unsigned* MISC = (volatile LAS unsigned*)(F.lds + LDS_MISC);
    if (F.tid < 64) MISC[F.tid] = 0u;
    __syncthreads();
    XcdBarrier bar; bar.bar = (unsigned*)(F.ws + WS_CTL) + CW_BAR; bar.x = 0; bar.st = nullptr;
    if (!MK_PER_PHASE) bar = xcd_barrier_post((unsigned*)(F.ws + WS_CTL) + CW_BAR, MISC + 8);
    const int lo = args.ph_lo, hi = args.ph_hi;
#define IN(k) (lo <= (k) && (k) < hi)
#define SEAM(k) do { if (IN(k) && IN((k) + 1)) xcd_barrier(bar); } while (0)
    using namespace pg8;
    const float* rope = (const float*)(F.ws + WS_ROPE);
    const int c = (int)blockIdx.x;

    if (IN(0)) { p0_prologue(F); } SEAM(0);
    if (IN(1)) {
        SchedDense S{T_TOK / 256, N_ATT / 256, F.G, c, 512, (const char*)(F.ws + WS_WINQ)};
        EpiProj<0> E{(bf16_t*)(F.ws + DY_ATTBUF), N_ATT, rope, (const float*)(F.ws + WS_RS0), (const float*)(F.ws + WS_SWIN)};
        gemm_phase<EpiProj<0>, SchedDense, true>(F.lds, (const char*)(F.dout + DO_HBQ), S, E);
    } SEAM(1);
    if (IN(2)) { attn_phase(F, 0); } SEAM(2);
    if (IN(3)) { attn_phase(F, 1); } SEAM(3);
    if (IN(4)) { attn_phase(F, 2); } SEAM(4);
    if (IN(5)) {
        { SchedDense S{T_TOK / 256, N_GATE / 256, F.G, c, 512, (const char*)(F.ws + WS_WINQ) + (size_t)7680 * 1024};
          EpiProj<0> E{(bf16_t*)(F.ws + DY_GATEBUF), N_GATE, rope, (const float*)(F.ws + WS_RS0), (const float*)(F.ws + WS_SWIN) + 7680};
          gemm_phase<EpiProj<0>, SchedDense, true>(F.lds, (const char*)(F.dout + DO_HBQ), S, E); }
        { SchedDense S{T_TOK / 256, N_RET / 256, F.G, c, 512, (const char*)(F.ws + WS_WINQ) + (size_t)4608 * 1024};
          EpiProj<2> E{(bf16_t*)(F.ws + DY_RETBUF), N_RET, rope, (const float*)(F.ws + WS_RS0), (const float*)(F.ws + WS_SWIN) + 4608};
          gemm_phase<EpiProj<2>, SchedDense, true>(F.lds, (const char*)(F.dout + DO_HBQ), S, E); }
    } SEAM(5);
    if (IN(6)) { ret_state_phase(F); } SEAM(6);
    if (IN(7)) { ret_out_phase(F); } SEAM(7);
    if (IN(8)) {
        { SchedDense S{T_TOK / 256, 4, F.G, c, 512, (const char*)(F.ws + WS_WATT)};
          EpiM1 E{(bf16_t*)(F.ws + DY_M1), (const bf16_t*)(F.ws + DY_GATEBUF)};
          gemm_phase(F.lds, (const char*)(F.ws + DY_ATT), S, E); }
        VM_WAIT(); __syncthreads();
        { SchedDense S{T_TOK / 256, 4, F.G, c, 1024, (const char*)(F.ws + WS_WRET)};
          EpiMerge E{(bf16_t*)(F.ws + DY_MERGED), (const bf16_t*)(F.ws + DY_GATEBUF), (const bf16_t*)(F.ws + DY_M1)};
          gemm_phase(F.lds, (const char*)(F.dout + DO_RETN), S, E); }
    } SEAM(8);
    if (IN(9)) {
        SchedDense S{T_TOK / 256, 4, F.G, c, 1024, (const char*)(F.ws + WS_WOUT)};
        EpiX1 E{F.in[0], (float*)F.dout};
        gemm_phase(F.lds, (const char*)(F.ws + DY_MERGED), S, E);
    } SEAM(9);
    if (IN(10)) { router_phase(F); } SEAM(10);
    if (IN(11)) { scatter_phase(F); } SEAM(11);
#define MOE_UP(half) do { \
        const int* tileE = (const int*)(F.ws + WS_TILE) + (half) * HALF_TILES; const int ntl = __builtin_amdgcn_readfirstlane(((const int*)(F.ws + WS_TILE))[2 * HALF_TILES + (half)]); \
        const int* tokS = (const int*)(F.ws + WS_SORT + (size_t)(half) * 3 * HALF_ROWS * 4); \
        SchedMoE S{ntl, 8, F.G, c, 512, (const char*)(F.ws + WS_W1), (size_t)2048 * 1024, tileE, tokS}; \
        EpiSwiglu E{(bf16_t*)(F.ws + DY_ACT), F.in[11], (const float*)(tokS + 2 * HALF_ROWS), (const float*)(F.ws + WS_SW1)}; \
        gemm_phase<EpiSwiglu, SchedMoE, true>(F.lds, (const char*)(F.ws + DY_X1B), S, E); } while (0)
#define MOE_DOWN(half) do { \
        const int* tileE = (const int*)(F.ws + WS_TILE) + (half) * HALF_TILES; const int ntl = __builtin_amdgcn_readfirstlane(((const int*)(F.ws + WS_TILE))[2 * HALF_TILES + (half)]); \
        const int* tokS = (const int*)(F.ws + WS_SORT + (size_t)(half) * 3 * HALF_ROWS * 4); \
        SchedMoE S{ntl, 4, F.G, c, 512, (const char*)(F.ws + WS_W2), (size_t)1024 * 1024, tileE, nullptr}; \
        EpiDown E{(bf16_t*)(F.ws + DY_Y), F.in[13], (const float*)(tokS + HALF_ROWS), (const float*)(F.ws + WS_SW2)}; \
        gemm_phase<EpiDown, SchedMoE, true>(F.lds, (const char*)(F.ws + DY_ACT), S, E); } while (0)
    if (IN(12)) { MOE_UP(0); } SEAM(12);
    if (IN(13)) { MOE_DOWN(0); } SEAM(13);
    if (IN(14)) { final_phase(F, 0); }
#undef IN
#undef SEAM
}


extern "C" void kernel_launch(void* const* d_in, const int* in_sizes, int n_in, void* d_out, int out_size, void* d_ws, size_t ws_size, hipStream_t stream) {
    static int grid = 0;
    if (grid == 0) {
        if (n_in != 15 || out_size != T_TOK * DM || ws_size < WS_END) { fprintf(stderr, "kernel_launch: unexpected shapes (n_in %d out %d ws %zu)\n", n_in, out_size, ws_size); grid = -1; return; }
        int dev = 0, cus = 0, per_cu = 0;
        if (hipGetDevice(&dev) != hipSuccess || hipDeviceGetAttribute(&cus, hipDeviceAttributeMultiprocessorCount, dev) != hipSuccess) { grid = -1; return; }
        if (hipFuncSetAttribute((const void*)mk_fwd, hipFuncAttributeMaxDynamicSharedMemorySize, LDS_BYTES) != hipSuccess) { fprintf(stderr, "kernel_launch: hipFuncSetAttribute failed\n"); grid = -1; return; }
        if (hipOccupancyMaxActiveBlocksPerMultiprocessor(&per_cu, (const void*)mk_fwd, 512, LDS_BYTES) != hipSuccess || per_cu < 1) { fprintf(stderr, "kernel_launch: occupancy query says %d\n", per_cu); }
        (void)hipGetLastError();
        grid = cus;
    }
    if (grid < 0) return;
    (void)hipMemsetAsync((char*)d_ws + WS_CTL, 0, CTL_BYTES, stream);
    Args a{};
    for (int i = 0; i < 15; ++i) a.in[i] = (const float*)d_in[i];
    a.out = (float*)d_out; a.ws = (unsigned char*)d_ws;
#if MK_PER_PHASE
    for (int p = 0; p < N_PHASES; ++p) { a.ph_lo = p; a.ph_hi = p + 1; hipLaunchKernelGGL(mk_fwd, dim3(grid), dim3(512), LDS_BYTES, stream, a); }
#else
    a.ph_lo = 0; a.ph_hi = N_PHASES;
    hipLaunchKernelGGL(mk_fwd, dim3(grid), dim3(512), LDS_BYTES, stream, a);
#endif
}
```

```cpp
#include <hip/hip_runtime.h>
#include <cstdio>
#include <cstdint>

#ifndef MK_PER_PHASE
#define MK_PER_PHASE 0
#endif

#define GAS __attribute__((address_space(1)))
#define LAS __attribute__((address_space(3)))
typedef unsigned short bf16_t;
typedef short bf16x8 __attribute__((ext_vector_type(8)));
typedef short s16x4 __attribute__((ext_vector_type(4)));
typedef float f32x4 __attribute__((ext_vector_type(4)));
typedef float f32x2 __attribute__((ext_vector_type(2)));
typedef unsigned u32x4 __attribute__((ext_vector_type(4)));
typedef unsigned u32x2 __attribute__((ext_vector_type(2)));
typedef int i32x4 __attribute__((ext_vector_type(4)));

constexpr int T_TOK = 65536, DM = 1024, SEQ = 4096, NB = 16;
constexpr int N_ATT = 4608, N_RET = 3072, N_GATE = 2048, PROJ_W = 9728;
constexpr int NEXP = 32, TOPK = 4, DEXP = 1024;
constexpr int HALF_TOK = 65536, HALF_ROWS = 270336, HALF_TILES = 1056;
constexpr float NORM_EPS = 1e-5f;
constexpr float LOG2E = 1.4426950408889634f;

constexpr size_t MiB = 1u << 20;
constexpr size_t WS_CTL = 0, CTL_BYTES = 1 * MiB;
constexpr size_t WS_ROPE = 1 * MiB;
constexpr size_t WS_BIAS = 3 * MiB;
constexpr size_t WS_WRL = 3 * MiB + 65536;
constexpr size_t WS_RSTD = 4 * MiB;
constexpr size_t WS_ASG = 5 * MiB;
constexpr size_t WS_SORT = 9 * MiB;
constexpr size_t WS_TILE = 13 * MiB;
constexpr size_t WS_LSE = 14 * MiB;
constexpr size_t WS_WATT = 16 * MiB;
constexpr size_t WS_WRET = 17 * MiB;
constexpr size_t WS_WOUT = 19 * MiB;
constexpr size_t WS_WIN = 21 * MiB;
constexpr size_t WS_W1 = 40 * MiB;
constexpr size_t WS_SW1 = 104 * MiB;
constexpr size_t WS_WINQ = 112 * MiB;
constexpr size_t WS_SWIN = 124 * MiB;
constexpr size_t WS_RS0 = 4 * MiB + 512 * 1024;
constexpr size_t WS_W2 = 168 * MiB;
constexpr size_t WS_SW2 = 125 * MiB;
constexpr float ACT_STEP = 12.0f / 127.0f;
constexpr size_t WS_DYN = 232 * MiB;
constexpr size_t DY_ATTBUF = WS_DYN;
constexpr size_t DY_ATT = WS_DYN + 720 * MiB;
constexpr size_t DY_RETBUF = WS_DYN;
constexpr size_t DY_GATEBUF = WS_DYN + 384 * MiB;
constexpr size_t DY_M1 = WS_DYN;
constexpr size_t DY_MERGED = WS_DYN + 128 * MiB;
constexpr size_t DY_X1B = 200 * MiB;
constexpr size_t DY_ACT = 728 * MiB;
constexpr size_t DY_Y = 200 * MiB;
constexpr size_t WS_END = WS_DYN + 792 * MiB;
static_assert(DY_Y + (size_t)HALF_ROWS * 2048 <= DY_ACT && DY_ACT + (size_t)HALF_ROWS * 1024 <= WS_END && WS_W2 + (size_t)NEXP * 1024 * 1024 <= DY_Y, "ws map");
static_assert(DY_ATTBUF + (size_t)T_TOK * N_ATT * 2 <= DY_ATT, "ws map");
constexpr size_t DO_HB = 0, DO_SR = 0, DO_RETN = 128 * MiB, DO_HBQ = 128 * MiB;

constexpr int CW_BAR = 1024;
constexpr int CW_GCNT = 8192;

constexpr int LDS_MAIN = 131072;
constexpr int LDS_AUX = LDS_MAIN;
constexpr int LDS_MISC = LDS_MAIN + 7168;
constexpr int LDS_BYTES = LDS_MAIN + 8192;

__device__ __forceinline__ float bf2f(unsigned short b) { return __uint_as_float(((unsigned)b) << 16); }
typedef __bf16 bf16x2_t __attribute__((ext_vector_type(2)));
__device__ __forceinline__ unsigned pk2(float lo, float hi) { const f32x2 v = {lo, hi}; const bf16x2_t b = __builtin_convertvector(v, bf16x2_t); return __builtin_bit_cast(unsigned, b); }
__device__ __forceinline__ float bflo(unsigned w) { return __uint_as_float(w << 16); }
__device__ __forceinline__ float bfhi(unsigned w) { return __uint_as_float(w & 0xffff0000u); }
__device__ __forceinline__ float fast_exp2(float x) { return __builtin_amdgcn_exp2f(x); }
__device__ __forceinline__ float fast_rcp(float x) { return __builtin_amdgcn_rcpf(x); }
__device__ __forceinline__ float sigmoidf_(float x) { return fast_rcp(1.0f + fast_exp2(-x * LOG2E)); }
__device__ __forceinline__ float wave_sum(float v) {
#pragma unroll
    for (int o = 1; o < 64; o <<= 1) v += __shfl_xor(v, o);
    return v;
}
#define LDS_WAIT() asm volatile("s_waitcnt lgkmcnt(0)" ::: "memory")
#define VM_WAIT() asm volatile("s_waitcnt vmcnt(0)" ::: "memory")

__device__ __forceinline__ unsigned off_b(unsigned row, unsigned ch) { return 256u * row + 16u * (ch ^ (((row & 3u) << 2) | ((row >> 2) & 3u))); }
__device__ __forceinline__ s16x4 tr_read(const LAS unsigned char* p) { return __builtin_amdgcn_ds_read_tr16_b64_v4i16((LAS s16x4*)p); }
__device__ __forceinline__ bf16x8 cat8(s16x4 a, s16x4 b) { return __builtin_shufflevector(a, b, 0, 1, 2, 3, 4, 5, 6, 7); }

#define XB_TMO      128
#define XB_XCNT(j)  (256  + 64 * (j))
#define XB_XSUB(j)  (1280 + 64 * (j))
#define XB_XGEN(j)  (2304 + 64 * (j))
#define XB_TOP      3328
#define XB_TOPGEN   3392
#define XCD_BAR_WORDS 3456
#define XB_SPIN_CAP (1u << 18)
__device__ __forceinline__ unsigned xb_ld(unsigned* p)              { return __hip_atomic_load(p, __ATOMIC_RELAXED, __HIP_MEMORY_SCOPE_AGENT); }
__device__ __forceinline__ unsigned xb_add(unsigned* p, unsigned v) { return __hip_atomic_fetch_add(p, v, __ATOMIC_RELAXED, __HIP_MEMORY_SCOPE_AGENT); }
__device__ __forceinline__ unsigned xb_xcc_id() { return (unsigned)__builtin_amdgcn_s_getreg((3 << 11) | 20) & 0xFu; }
#define XB_SPIN(cond, bar) do { unsigned _sp = 0; while (cond) { __builtin_amdgcn_s_sleep(1); \
    if ((++_sp & 255u) == 0u) { if (xb_ld(&(bar)[XB_TMO])) break; if (_sp > XB_SPIN_CAP) { atomicAdd(&(bar)[XB_TMO], 1u); break; } } } } while (0)
struct XcdBarrier { unsigned* bar; unsigned x; volatile LAS unsigned* st; };
__device__ __forceinline__ XcdBarrier xcd_barrier_post(unsigned* bar, volatile LAS unsigned* st) {
    XcdBarrier b; b.bar = bar; b.x = xb_xcc_id(); b.st = st;
    if (threadIdx.x == 0) (void)xb_add(&bar[XB_XCNT(b.x)], 1u);
    return b;
}
__device__ __forceinline__ void xcd_barrier_complete(unsigned* bar, unsigned x, unsigned& nloc, unsigned& nx) {
    const unsigned G = gridDim.x * gridDim.y * gridDim.z;
    unsigned sum, cnt, mine, sp = 0u;
    for (;;) {
        sum = 0u; cnt = 0u; mine = 0u;
#pragma unroll
        for (unsigned j = 0; j < 16; ++j) { const unsigned c = xb_ld(&bar[XB_XCNT(j)]); sum += c; cnt += (c > 0u) ? 1u : 0u; mine = (j == x) ? c : mine; }
        if (sum == G) break;
        __builtin_amdgcn_s_sleep(1);
        if ((++sp & 255u) == 0u) { if (xb_ld(&bar[XB_TMO])) break; if (sp > XB_SPIN_CAP) { atomicAdd(&bar[XB_TMO], 1u); break; } }
    }
    nloc = mine > 0u ? mine : 1u; nx = cnt > 0u ? cnt : 1u;
}
__device__ __forceinline__ void xcd_barrier(const XcdBarrier& b) {
    asm volatile("s_waitcnt vmcnt(0)" ::: "memory");
    __syncthreads();
    if (threadIdx.x == 0) {
        unsigned* bar = b.bar;
        __builtin_amdgcn_s_waitcnt(0);
        unsigned nloc = b.st[0], nx = b.st[1];
        if (nloc == 0u) { xcd_barrier_complete(bar, b.x, nloc, nx); b.st[0] = nloc; b.st[1] = nx; }
        const unsigned old = xb_add(&bar[XB_XSUB(b.x)], 1u);
        const unsigned gen = old / nloc;
        if (old + 1u == (gen + 1u) * nloc) {
            __builtin_amdgcn_fence(__ATOMIC_RELEASE, "agent");
            asm volatile("s_waitcnt vmcnt(0)" ::: "memory");
            const unsigned og = xb_add(&bar[XB_TOP], 1u);
            const unsigned tg = og / nx;
            if (og + 1u == (tg + 1u) * nx) xb_add(&bar[XB_TOPGEN], 1u);
            else XB_SPIN(xb_ld(&bar[XB_TOPGEN]) == tg, bar);
            __builtin_amdgcn_fence(__ATOMIC_ACQUIRE, "agent");
            xb_add(&bar[XB_XGEN(b.x)], 1u);
            asm volatile("s_waitcnt vmcnt(0)" ::: "memory");
        } else {
            XB_SPIN(xb_ld(&bar[XB_XGEN(b.x)]) == gen, bar);
            __builtin_amdgcn_fence(__ATOMIC_ACQUIRE, "agent");
            asm volatile("s_waitcnt vmcnt(0)" ::: "memory");
        }
    }
    __syncthreads();
}

namespace pg8 {
constexpr int BM = 256, BK = 64, HALF = 128, HTB = HALF * BK * 2, STAGE_BYTES = 8 * HTB, NXCD = 8, WGM = 8;
__device__ __forceinline__ int lds_byte(int r, int c) { const int st = (r >> 4) * 2 + (c >> 5), rr = r & 15, cc = c & 31, ob = rr * 64 + cc * 2; return st * 1024 + (ob ^ (((ob >> 9) & 1) << 5)); }
__device__ __forceinline__ void stage_rc(int b, int& R, int& C) { const int st = b / 1024, sb = b % 1024, swz = sb ^ (((sb >> 9) & 1) << 5); R = (st >> 1) * 16 + swz / 64; C = (st & 1) * 32 + (swz % 64) / 2; }
__device__ __forceinline__ int perm32(int rho) { const int n = rho >> 4, i = rho & 15; return 8 * (i >> 2) + 4 * n + (i & 3); }
struct Unit { int pm, pn, e; };

__device__ __forceinline__ bool unit_of(long L, int nM, int nN, Unit& u) {
    const int nwg = nM * nN; if (L >= nwg) return false;
    int wgid = (int)L; { const int q = nwg / NXCD, r = nwg % NXCD, xcd = wgid % NXCD, off = wgid / NXCD; wgid = (xcd < r ? xcd * (q + 1) : r * (q + 1) + (xcd - r) * q) + off; }
    const int nig = WGM * nN, gid = wgid / nig, fm = gid * WGM, gsz = (nM - fm) < WGM ? (nM - fm) : WGM;
    u.pm = fm + ((wgid % nig) % gsz); u.pn = (wgid % nig) / gsz; u.e = 0; return true;
}
struct SchedDense {
    int nM, nN, G, c, K; const char* Bt;
    __device__ __forceinline__ bool next(int i, Unit& u) const { return unit_of((long)i * G + c, nM, nN, u); }
    __device__ __forceinline__ const char* bbase(const Unit& u) const { return Bt + (size_t)u.pn * 256 * K * 2; }
    __device__ __forceinline__ void aoff(const Unit& u, const int (&R)[2], const int (&C)[2], unsigned (&v)[2][2]) const {
#pragma unroll
        for (int h = 0; h < 2; ++h)
#pragma unroll
            for (int i = 0; i < 2; ++i) v[h][i] = (unsigned)((u.pm * 256 + h * 128 + R[i]) * K + C[i]) * 2u;
    }
    __device__ __forceinline__ void araw(const Unit& u, const int (&R)[2], int (&w)[2][2]) const {
#pragma unroll
        for (int h = 0; h < 2; ++h)
#pragma unroll
            for (int i = 0; i < 2; ++i) w[h][i] = u.pm * 256 + h * 128 + R[i];
    }
    __device__ __forceinline__ void afin(const int (&w)[2][2], const int (&C)[2], unsigned (&v)[2][2]) const {
#pragma unroll
        for (int h = 0; h < 2; ++h)
#pragma unroll
            for (int i = 0; i < 2; ++i) v[h][i] = (unsigned)(w[h][i] * K + C[i]) * 2u;
    }
};
struct SchedMoE {
    int nM, nN, G, c, K; const char* Bt; size_t estride; const int* tile_expert; const int* rowidx;
    __device__ __forceinline__ bool next(int i, Unit& u) const { if (!unit_of((long)i * G + c, nM, nN, u)) return false; u.e = __builtin_amdgcn_readfirstlane(tile_expert[u.pm]); return true; }
    __device__ __forceinline__ const char* bbase(const Unit& u) const { return Bt + (size_t)u.e * estride + (size_t)u.pn * 256 * K * 2; }
    __device__ __forceinline__ void aoff(const Unit& u, const int (&R)[2], const int (&C)[2], unsigned (&v)[2][2]) const {
#pragma unroll
        for (int h = 0; h < 2; ++h)
#pragma unroll
            for (int i = 0; i < 2; ++i) { const int r = u.pm * 256 + h * 128 + R[i]; const int src = rowidx ? rowidx[r] : r; v[h][i] = (unsigned)(src * K + C[i]) * 2u; }
    }
    __device__ __forceinline__ void araw(const Unit& u, const int (&R)[2], int (&w)[2][2]) const {
#pragma unroll
        for (int h = 0; h < 2; ++h)
#pragma unroll
            for (int i = 0; i < 2; ++i) { const int r = u.pm * 256 + h * 128 + R[i]; w[h][i] = rowidx ? rowidx[r] : r; }
    }
    __device__ __forceinline__ void afin(const int (&w)[2][2], const int (&C)[2], unsigned (&v)[2][2]) const {
#pragma unroll
        for (int h = 0; h < 2; ++h)
#pragma unroll
            for (int i = 0; i < 2; ++i) v[h][i] = (unsigned)(w[h][i] * K + C[i]) * 2u;
    }
};

template <bool I8> struct AccSel { typedef f32x4 T; };
template <> struct AccSel<true> { typedef i32x4 T; };
template <class Epi, class Sched, bool I8 = false>
__device__ __forceinline__ void gemm_phase(LAS unsigned char* lds, const char* gA, const Sched& S, const Epi& E) {
    typedef typename AccSel<I8>::T acc_t;
    const int tid = threadIdx.x, wid = __builtin_amdgcn_readfirstlane(tid >> 6), lane = tid & 63, wr = wid >> 2, wc = wid & 3, fr = lane & 15, fq = lane >> 4;
    const int K = S.K, nt = K / BK;
    int Rr[2], Cc[2]; unsigned voffB[2];
#pragma unroll
    for (int i = 0; i < 2; ++i) { int R, C; stage_rc(tid * 16 + i * 8192, R, C); Rr[i] = R; Cc[i] = C; const int Rb = (R & ~31) + perm32(R & 31); voffB[i] = (unsigned)(Rb * K + C) * 2u; }
    const size_t kstep = (size_t)(BK * 2);
    const size_t hstep = (size_t)HALF * K * 2;
    const unsigned ldsw = (unsigned)wid * 1024u;
    const int aoff = lds_byte(wr * 64 + fr, fq * 8), boff = lds_byte(wc * 32 + fr, fq * 8);
#define PG8_SA(b, h) (((b) * 2 + (h)) * HTB)
#define PG8_SB(b, h) ((4 + (b) * 2 + (h)) * HTB)
#define PG8_STAGE_B(bufoff, gbase) do { _Pragma("unroll") for (int _i = 0; _i < 2; ++_i) \
        __builtin_amdgcn_global_load_lds((const unsigned*)((const char*)(gbase) + voffB[_i]), (LAS unsigned*)(lds + (bufoff) + ldsw + _i * 8192), 16, 0, 0); } while (0)
#define PG8_STAGE_A(bufoff, gbase, vv) do { _Pragma("unroll") for (int _i = 0; _i < 2; ++_i) \
        __builtin_amdgcn_global_load_lds((const unsigned*)((const char*)(gbase) + (vv)[_i]), (LAS unsigned*)(lds + (bufoff) + ldsw + _i * 8192), 16, 0, 0); } while (0)
#define PG8_LDA(dst, b, h) do { _Pragma("unroll") for (int m = 0; m < 4; ++m) _Pragma("unroll") for (int k = 0; k < 2; ++k) dst[m][k] = *(const LAS bf16x8*)(lds + PG8_SA(b, h) + aoff + m * 2048 + k * 1024); } while (0)
#define PG8_LDB(dst, b, h) do { _Pragma("unroll") for (int n = 0; n < 2; ++n) _Pragma("unroll") for (int k = 0; k < 2; ++k) dst[n][k] = *(const LAS bf16x8*)(lds + PG8_SB(b, h) + boff + n * 2048 + k * 1024); } while (0)
#define PG8_MMA(ai, bj, At, Bt) do { __builtin_amdgcn_s_setprio(1); _Pragma("unroll") for (int m = 0; m < 4; ++m) _Pragma("unroll") for (int n = 0; n < 2; ++n) _Pragma("unroll") for (int k = 0; k < 2; ++k) { \
        if constexpr (I8) acc[ai][bj][m][n] = __builtin_amdgcn_mfma_i32_16x16x64_i8(__builtin_bit_cast(i32x4, Bt[n][k]), __builtin_bit_cast(i32x4, At[m][k]), acc[ai][bj][m][n], 0, 0, 0); \
        else acc[ai][bj][m][n] = __builtin_amdgcn_mfma_f32_16x16x32_bf16(Bt[n][k], At[m][k], acc[ai][bj][m][n], 0, 0, 0); } __builtin_amdgcn_s_setprio(0); } while (0)
#define PG8_WAIT_V(n) asm volatile("s_waitcnt vmcnt(" #n ")" ::: "memory")
#define PG8_WAIT_L(n) asm volatile("s_waitcnt lgkmcnt(" #n ")" ::: "memory")
#define PG8_BAR __builtin_amdgcn_s_barrier()
#define PG8_SCHED __builtin_amdgcn_sched_barrier(0)
    Unit cur, nxt, nn; int ui = 0;
    if (!S.next(0, cur)) return;
    const int ntm = nt - 1;
    int rc = (cur.pm + 2 * cur.pn) & ntm, rn = rc;
    acc_t acc[2][2][4][2];
#pragma unroll
    for (int a = 0; a < 2; ++a)
#pragma unroll
        for (int b = 0; b < 2; ++b)
#pragma unroll
            for (int m = 0; m < 4; ++m)
#pragma unroll
                for (int n = 0; n < 2; ++n) acc[a][b][m][n] = (acc_t){0, 0, 0, 0};
    bf16x8 At[4][2], B0[2][2], B1[2][2];
    unsigned vc[2][2], vn[2][2]; int rw[2][2];
    S.aoff(cur, Rr, Cc, vc);
    const char* cB = S.bbase(cur);
    bool has_next = S.next(1, nxt);
    const char* nB = cB;
    if (has_next) { S.aoff(nxt, Rr, Cc, vn); nB = S.bbase(nxt); rn = (nxt.pm + 2 * nxt.pn) & ntm; }
    else {
#pragma unroll
        for (int h = 0; h < 2; ++h)
#pragma unroll
            for (int i = 0; i < 2; ++i) vn[h][i] = vc[h][i];
    }
    { const size_t k0 = (size_t)rc * kstep, k1 = (size_t)((rc + 1) & ntm) * kstep;
    PG8_STAGE_B(PG8_SB(0, 0), cB + k0); PG8_STAGE_B(PG8_SB(0, 1), cB + hstep + k0); PG8_STAGE_A(PG8_SA(0, 0), gA + k0, vc[0]); PG8_STAGE_A(PG8_SA(0, 1), gA + k0, vc[1]);
    PG8_STAGE_B(PG8_SB(1, 0), cB + k1); PG8_STAGE_B(PG8_SB(1, 1), cB + hstep + k1); PG8_STAGE_A(PG8_SA(1, 0), gA + k1, vc[0]); }
    if (wr == 1) PG8_BAR;
    PG8_WAIT_V(8); PG8_BAR; PG8_BAR;
    for (;;) {
        const bool has_nn = has_next && S.next(ui + 2, nn);
        const char* nnB = nB;
        if (has_nn) { S.araw(nn, Rr, rw); nnB = S.bbase(nn); }
        else {
#pragma unroll
            for (int h = 0; h < 2; ++h)
#pragma unroll
                for (int i = 0; i < 2; ++i) rw[h][i] = 0;
        }
        for (int t = 0; t < nt; t += 2) {
            const bool last = (t == nt - 2);
            const size_t ko1 = (size_t)((rc + t + 1) & ntm) * kstep;
            const size_t ko2 = (size_t)(last ? rn : ((rc + t + 2) & ntm)) * kstep, ko3 = (size_t)(last ? ((rn + 1) & ntm) : ((rc + t + 3) & ntm)) * kstep;
            const char* a1 = gA + ko1;
            const char* a2 = gA + ko2;
            const char* a3 = gA + ko3;
            unsigned v2[2][2];
#pragma unroll
            for (int h = 0; h < 2; ++h)
#pragma unroll
                for (int i = 0; i < 2; ++i) v2[h][i] = last ? vn[h][i] : vc[h][i];
            const char* bb = last ? nB : cB;
            PG8_LDB(B0, 0, 0); PG8_LDB(B1, 0, 1); PG8_LDA(At, 0, 0); PG8_STAGE_A(PG8_SA(1, 1), a1, vc[1]);
            PG8_WAIT_V(8); PG8_WAIT_L(0); PG8_BAR; PG8_SCHED; PG8_MMA(0, 0, At, B0); PG8_MMA(0, 1, At, B1); PG8_BAR; PG8_SCHED;
            PG8_LDA(At, 0, 1); PG8_STAGE_B(PG8_SB(0, 0), bb + ko2); PG8_STAGE_B(PG8_SB(0, 1), bb + ko2 + hstep); PG8_STAGE_A(PG8_SA(0, 0), a2, v2[0]);
            PG8_WAIT_V(8); PG8_WAIT_L(0); PG8_BAR; PG8_SCHED; PG8_MMA(1, 0, At, B0); PG8_MMA(1, 1, At, B1); PG8_BAR; PG8_SCHED;
            PG8_LDB(B0, 1, 0); PG8_LDB(B1, 1, 1); PG8_LDA(At, 1, 0); PG8_STAGE_A(PG8_SA(0, 1), a2, v2[1]);
            PG8_WAIT_V(8); PG8_WAIT_L(0); PG8_BAR; PG8_SCHED; PG8_MMA(0, 0, At, B0); PG8_MMA(0, 1, At, B1); PG8_BAR; PG8_SCHED;
            PG8_LDA(At, 1, 1); PG8_STAGE_B(PG8_SB(1, 0), bb + ko3); PG8_STAGE_B(PG8_SB(1, 1), bb + ko3 + hstep); PG8_STAGE_A(PG8_SA(1, 0), a3, v2[0]);
            PG8_WAIT_V(8); PG8_WAIT_L(0); PG8_BAR; PG8_SCHED; PG8_MMA(1, 0, At, B0); PG8_MMA(1, 1, At, B1); PG8_BAR; PG8_SCHED;
        }
        E(acc, cur, wr, wc, fr, fq);
        if (!has_next) break;
#pragma unroll
        for (int a = 0; a < 2; ++a)
#pragma unroll
            for (int b = 0; b < 2; ++b)
#pragma unroll
                for (int m = 0; m < 4; ++m)
#pragma unroll
                    for (int n = 0; n < 2; ++n) acc[a][b][m][n] = (acc_t){0, 0, 0, 0};
        cur = nxt; cB = nB; rc = rn; ++ui;
#pragma unroll
        for (int h = 0; h < 2; ++h)
#pragma unroll
            for (int i = 0; i < 2; ++i) vc[h][i] = vn[h][i];
        has_next = has_nn;
        if (has_nn) { nxt = nn; nB = nnB; S.afin(rw, Cc, vn); rn = (nn.pm + 2 * nn.pn) & ntm; }
    }
    PG8_WAIT_V(0);
    if (wr == 0) PG8_BAR;
    PG8_BAR;
#undef PG8_SA
#undef PG8_SB
#undef PG8_STAGE_A
#undef PG8_STAGE_B
#undef PG8_LDA
#undef PG8_LDB
#undef PG8_MMA
#undef PG8_WAIT_V
#undef PG8_WAIT_L
#undef PG8_BAR
#undef PG8_SCHED
}

#define EPI_LOOP_BEGIN \
    _Pragma("unroll") for (int ai = 0; ai < 2; ++ai) _Pragma("unroll") for (int m = 0; m < 4; ++m) { const int row = u.pm * BM + ai * HALF + wr * 64 + m * 16 + fr; \
    _Pragma("unroll") for (int bj = 0; bj < 2; ++bj) { const int col = u.pn * BM + bj * HALF + wc * 32 + 8 * fq; f32x4 v0 = acc[ai][bj][m][0], v1 = acc[ai][bj][m][1];
#define EPI_LOOP_END } }
__device__ __forceinline__ u32x4 pack8(f32x4 v0, f32x4 v1) { u32x4 w; w.x = pk2(v0[0], v0[1]); w.y = pk2(v0[2], v0[3]); w.z = pk2(v1[0], v1[1]); w.w = pk2(v1[2], v1[3]); return w; }

template <int MODE> struct EpiProj {
    bf16_t* O; int ldc; const float* rope; const float* rs0; const float* sw;
    __device__ __forceinline__ void operator()(const i32x4 (&acc)[2][2][4][2], const Unit& u, int wr, int wc, int fr, int fq) const {
        const int row0 = u.pm * BM + wr * 64 + fr, colb = u.pn * BM + wc * 32 + 8 * fq;
        float rsr[8]; f32x4 s0[2], s1[2];
#pragma unroll
        for (int i = 0; i < 8; ++i) rsr[i] = rs0[row0 + (i >> 2) * HALF + (i & 3) * 16];
#pragma unroll
        for (int bj = 0; bj < 2; ++bj) { s0[bj] = *(const f32x4*)(sw + colb + bj * HALF); s1[bj] = *(const f32x4*)(sw + colb + bj * HALF + 4); }
#pragma unroll
        for (int ai = 0; ai < 2; ++ai) {
            f32x4 csv[4][2], snv[4][2];
            if (MODE == 2 && u.pn < 4) {
#pragma unroll
                for (int m = 0; m < 4; ++m)
#pragma unroll
                    for (int bj = 0; bj < 2; ++bj) { const int s = (row0 + ai * HALF + m * 16) & (SEQ - 1), i0 = ((colb + bj * HALF) & 127) >> 1; csv[m][bj] = *(const f32x4*)(rope + s * 64 + i0); snv[m][bj] = *(const f32x4*)(rope + SEQ * 64 + s * 64 + i0); }
            }
#pragma unroll
        for (int m = 0; m < 4; ++m) { const int row = row0 + ai * HALF + m * 16; const float rsv = rsr[ai * 4 + m];
#pragma unroll
        for (int bj = 0; bj < 2; ++bj) { const int col = colb + bj * HALF;
            f32x4 v0, v1;
#pragma unroll
            for (int j = 0; j < 4; ++j) { v0[j] = (float)acc[ai][bj][m][0][j] * (s0[bj][j] * rsv); v1[j] = (float)acc[ai][bj][m][1][j] * (s1[bj][j] * rsv); }
            if (MODE == 2) {
                if (u.pn < 4) {
                    const int head = 2 * (u.pn & 1) + bj;
                    const float lg = __builtin_log2f(1.0f - __builtin_amdgcn_exp2f(-5.0f - (float)head));
                    const float ii = (float)(row & 127);
                    const float fac = __builtin_amdgcn_exp2f((u.pn < 2 ? ii : -ii) * lg);
                    const f32x4 c4 = csv[m][bj], s4 = snv[m][bj];
                    f32x4 r0, r1;
                    r0[0] = (v0[0] * c4[0] - v0[1] * s4[0]) * fac; r0[1] = (v0[0] * s4[0] + v0[1] * c4[0]) * fac;
                    r0[2] = (v0[2] * c4[1] - v0[3] * s4[1]) * fac; r0[3] = (v0[2] * s4[1] + v0[3] * c4[1]) * fac;
                    r1[0] = (v1[0] * c4[2] - v1[1] * s4[2]) * fac; r1[1] = (v1[0] * s4[2] + v1[1] * c4[2]) * fac;
                    r1[2] = (v1[2] * c4[3] - v1[3] * s4[3]) * fac; r1[3] = (v1[2] * s4[3] + v1[3] * c4[3]) * fac;
                    v0 = r0; v1 = r1;
                } else if (u.pn >= 8) {
#pragma unroll
                    for (int j = 0; j < 4; ++j) { v0[j] = v0[j] * sigmoidf_(v0[j]); v1[j] = v1[j] * sigmoidf_(v1[j]); }
                }
            }
            *(u32x4*)(O + (size_t)row * ldc + col) = pack8(v0, v1);
        } } }
    }
};
struct EpiM1 {
    bf16_t* O; const bf16_t* gate;
    __device__ __forceinline__ void operator()(const f32x4 (&acc)[2][2][4][2], const Unit& u, int wr, int wc, int fr, int fq) const {
        const int row0 = u.pm * BM + wr * 64 + fr, colb = u.pn * BM + wc * 32 + 8 * fq;
#pragma unroll
        for (int ai = 0; ai < 2; ++ai) {
            u32x4 gw[4][2];
#pragma unroll
            for (int m = 0; m < 4; ++m)
#pragma unroll
                for (int bj = 0; bj < 2; ++bj) gw[m][bj] = *(const u32x4*)(gate + (size_t)(row0 + ai * HALF + m * 16) * N_GATE + colb + bj * HALF);
#pragma unroll
            for (int m = 0; m < 4; ++m)
#pragma unroll
                for (int bj = 0; bj < 2; ++bj) { const u32x4 g = gw[m][bj]; f32x4 v0 = acc[ai][bj][m][0], v1 = acc[ai][bj][m][1];
                    v0[0] *= sigmoidf_(bflo(g.x)); v0[1] *= sigmoidf_(bfhi(g.x)); v0[2] *= sigmoidf_(bflo(g.y)); v0[3] *= sigmoidf_(bfhi(g.y));
                    v1[0] *= sigmoidf_(bflo(g.z)); v1[1] *= sigmoidf_(bfhi(g.z)); v1[2] *= sigmoidf_(bflo(g.w)); v1[3] *= sigmoidf_(bfhi(g.w));
                    *(u32x4*)(O + (size_t)(row0 + ai * HALF + m * 16) * DM + colb + bj * HALF) = pack8(v0, v1); }
        }
    }
};
struct EpiMerge {
    bf16_t* O; const bf16_t* gate; const bf16_t* M1;
    __device__ __forceinline__ void operator()(const f32x4 (&acc)[2][2][4][2], const Unit& u, int wr, int wc, int fr, int fq) const {
        const int row0 = u.pm * BM + wr * 64 + fr, colb = u.pn * BM + wc * 32 + 8 * fq;
#pragma unroll
        for (int ai = 0; ai < 2; ++ai)
#pragma unroll
        for (int mh = 0; mh < 2; ++mh) {
            u32x4 gw[2][2], mw[2][2];
#pragma unroll
            for (int m2 = 0; m2 < 2; ++m2)
#pragma unroll
                for (int bj = 0; bj < 2; ++bj) { const size_t r = (size_t)(row0 + ai * HALF + (mh * 2 + m2) * 16); gw[m2][bj] = *(const u32x4*)(gate + r * N_GATE + 1024 + colb + bj * HALF); mw[m2][bj] = *(const u32x4*)(M1 + r * DM + colb + bj * HALF); }
#pragma unroll
            for (int m2 = 0; m2 < 2; ++m2)
#pragma unroll
                for (int bj = 0; bj < 2; ++bj) { const int m = mh * 2 + m2; const u32x4 g = gw[m2][bj], q = mw[m2][bj]; f32x4 v0 = acc[ai][bj][m][0], v1 = acc[ai][bj][m][1];
                    v0[0] = v0[0] * sigmoidf_(bflo(g.x)) + bflo(q.x); v0[1] = v0[1] * sigmoidf_(bfhi(g.x)) + bfhi(q.x); v0[2] = v0[2] * sigmoidf_(bflo(g.y)) + bflo(q.y); v0[3] = v0[3] * sigmoidf_(bfhi(g.y)) + bfhi(q.y);
                    v1[0] = v1[0] * sigmoidf_(bflo(g.z)) + bflo(q.z); v1[1] = v1[1] * sigmoidf_(bfhi(g.z)) + bfhi(q.z); v1[2] = v1[2] * sigmoidf_(bflo(g.w)) + bflo(q.w); v1[3] = v1[3] * sigmoidf_(bfhi(g.w)) + bfhi(q.w);
                    *(u32x4*)(O + (size_t)(row0 + ai * HALF + m * 16) * DM + colb + bj * HALF) = pack8(v0, v1); }
        }
    }
};
struct EpiX1 {
    const float* x; float* x1;
    __device__ __forceinline__ void operator()(const f32x4 (&acc)[2][2][4][2], const Unit& u, int wr, int wc, int fr, int fq) const {
        const int row0 = u.pm * BM + wr * 64 + fr, colb = u.pn * BM + wc * 32 + 8 * fq;
#pragma unroll
        for (int ai = 0; ai < 2; ++ai)
#pragma unroll
        for (int mh = 0; mh < 2; ++mh) {
            f32x4 xv[2][2][2];
#pragma unroll
            for (int m2 = 0; m2 < 2; ++m2)
#pragma unroll
                for (int bj = 0; bj < 2; ++bj) { const size_t o = (size_t)(row0 + ai * HALF + (mh * 2 + m2) * 16) * DM + colb + bj * HALF; xv[m2][bj][0] = *(const f32x4*)(x + o); xv[m2][bj][1] = *(const f32x4*)(x + o + 4); }
#pragma unroll
            for (int m2 = 0; m2 < 2; ++m2)
#pragma unroll
                for (int bj = 0; bj < 2; ++bj) { const int m = mh * 2 + m2; const size_t o = (size_t)(row0 + ai * HALF + m * 16) * DM + colb + bj * HALF;
                    *(f32x4*)(x1 + o) = acc[ai][bj][m][0] + xv[m2][bj][0]; *(f32x4*)(x1 + o + 4) = acc[ai][bj][m][1] + xv[m2][bj][1]; }
        }
    }
};
struct EpiSwiglu {
    bf16_t* act; const float* b1; const float* rs; const float* sw;
    __device__ __forceinline__ void operator()(const i32x4 (&acc)[2][2][4][2], const Unit& u, int wr, int wc, int fr, int fq) const {
        const int c0 = u.pn * 128 + wc * 32 + 8 * fq;
        const float* bg = b1 + (size_t)u.e * 2048 + c0; const float* bu = bg + 1024;
        const f32x4 bg0 = *(const f32x4*)bg, bg1 = *(const f32x4*)(bg + 4), bu0 = *(const f32x4*)bu, bu1 = *(const f32x4*)(bu + 4);
        const float* sg = sw + (size_t)u.e * 2048 + u.pn * 256 + wc * 32 + 8 * fq; const float* su = sg + 128;
        const f32x4 sg0 = *(const f32x4*)sg, sg1 = *(const f32x4*)(sg + 4), su0 = *(const f32x4*)su, su1 = *(const f32x4*)(su + 4);
        float rsr[8];
#pragma unroll
        for (int i = 0; i < 8; ++i) rsr[i] = rs[u.pm * BM + (i >> 2) * HALF + wr * 64 + (i & 3) * 16 + fr];
#pragma unroll
        for (int ai = 0; ai < 2; ++ai)
#pragma unroll
            for (int m = 0; m < 4; ++m) {
                const int row = u.pm * BM + ai * HALF + wr * 64 + m * 16 + fr;
                const float r = rsr[ai * 4 + m];
                f32x4 a0, a1;
#pragma unroll
                for (int j = 0; j < 4; ++j) {
                    float g = fminf((float)acc[ai][0][m][0][j] * (r * sg0[j]) + bg0[j], 7.0f), up = fminf(fmaxf((float)acc[ai][1][m][0][j] * (r * su0[j]) + bu0[j], -7.0f), 7.0f);
                    a0[j] = (up + 1.0f) * g * sigmoidf_(1.702f * g);
                    g = fminf((float)acc[ai][0][m][1][j] * (r * sg1[j]) + bg1[j], 7.0f); up = fminf(fmaxf((float)acc[ai][1][m][1][j] * (r * su1[j]) + bu1[j], -7.0f), 7.0f);
                    a1[j] = (up + 1.0f) * g * sigmoidf_(1.702f * g);
                }
                const float qs = 1.0f / ACT_STEP;
                int q[8];
#pragma unroll
                for (int j = 0; j < 4; ++j) { q[j] = __float2int_rn(fminf(fmaxf(a0[j] * qs, -127.0f), 127.0f)); q[4 + j] = __float2int_rn(fminf(fmaxf(a1[j] * qs, -127.0f), 127.0f)); }
                u32x2 ow; ow.x = (unsigned)(q[0] & 255) | ((unsigned)(q[1] & 255) << 8) | ((unsigned)(q[2] & 255) << 16) | ((unsigned)q[3] << 24);
                ow.y = (unsigned)(q[4] & 255) | ((unsigned)(q[5] & 255) << 8) | ((unsigned)(q[6] & 255) << 16) | ((unsigned)q[7] << 24);
                *(u32x2*)((signed char*)act + (size_t)row * DEXP + c0) = ow;
            }
    }
};
struct EpiDown {
    bf16_t* Y; const float* b2; const float* w; const float* sw;
    __device__ __forceinline__ void operator()(const i32x4 (&acc)[2][2][4][2], const Unit& u, int wr, int wc, int fr, int fq) const {
        const int row0 = u.pm * BM + wr * 64 + fr, colb = u.pn * BM + wc * 32 + 8 * fq;
        float wt[8]; f32x4 s0[2], s1[2], b0[2], b1v[2];
#pragma unroll
        for (int i = 0; i < 8; ++i) wt[i] = w[row0 + (i >> 2) * HALF + (i & 3) * 16];
#pragma unroll
        for (int bj = 0; bj < 2; ++bj) { const float* bb = b2 + (size_t)u.e * DM + colb + bj * HALF; const float* sp = sw + (size_t)u.e * DM + colb + bj * HALF;
            s0[bj] = *(const f32x4*)sp * ACT_STEP; s1[bj] = *(const f32x4*)(sp + 4) * ACT_STEP; b0[bj] = *(const f32x4*)bb; b1v[bj] = *(const f32x4*)(bb + 4); }
#pragma unroll
        for (int ai = 0; ai < 2; ++ai)
#pragma unroll
        for (int m = 0; m < 4; ++m) { const int row = row0 + ai * HALF + m * 16; const float wv = wt[ai * 4 + m];
#pragma unroll
        for (int bj = 0; bj < 2; ++bj) { const int col = colb + bj * HALF;
            f32x4 v0, v1;
#pragma unroll
            for (int j = 0; j < 4; ++j) { v0[j] = ((float)acc[ai][bj][m][0][j] * s0[bj][j] + b0[bj][j]) * wv; v1[j] = ((float)acc[ai][bj][m][1][j] * s1[bj][j] + b1v[bj][j]) * wv; }
            *(u32x4*)(Y + (size_t)row * DM + col) = pack8(v0, v1);
        } }
    }
};
}

__device__ const unsigned char T5B[3][129] = {
{0,1,2,3,4,5,6,7,8,9,10,11,12,13,14,15,16,16,16,16,16,16,17,17,17,17,17,17,17,17,18,18,18,18,18,18,18,18,18,18,19,19,19,19,19,19,19,19,19,19,19,19,19,19,20,20,20,20,20,20,20,20,20,20,20,20,20,20,20,20,20,20,20,21,21,21,21,21,21,21,21,21,21,21,21,21,21,21,21,21,21,21,21,21,21,21,21,21,21,22,22,22,22,22,22,22,22,22,22,22,22,22,22,22,22,22,22,22,22,22,22,22,22,22,22,22,22,22,22},
{0,4,8,12,16,16,17,17,18,18,19,19,19,19,20,20,20,20,20,21,21,21,21,21,21,22,22,22,22,22,22,22,22,22,23,23,23,23,23,23,23,23,23,23,23,23,24,24,24,24,24,24,24,24,24,24,24,24,24,24,24,24,25,25,25,25,25,25,25,25,25,25,25,25,25,25,25,25,25,25,25,25,25,26,26,26,26,26,26,26,26,26,26,26,26,26,26,26,26,26,26,26,26,26,26,26,26,26,26,26,26,26,26,27,27,27,27,27,27,27,27,27,27,27,27,27,27,27,27},
{0,16,18,19,20,21,21,22,22,23,23,23,24,24,24,24,25,25,25,25,25,26,26,26,26,26,26,26,26,27,27,27,27,27,27,27,27,27,27,28,28,28,28,28,28,28,28,28,28,28,28,28,29,29,29,29,29,29,29,29,29,29,29,29,29,29,29,29,29,29,30,30,30,30,30,30,30,30,30,30,30,30,30,30,30,30,30,30,30,30,30,30,30,30,30,31,31,31,31,31,31,31,31,31,31,31,31,31,31,31,31,31,31,31,31,31,31,31,31,31,31,31,31,31,31,31,31,31,31}};

struct Frame {
    LAS unsigned char* lds;
    int tid, lane, wave, G;
    unsigned char* ws; unsigned char* dout;
    const float* in[15];
};
struct Args { const float* in[15]; float* out; unsigned char* ws; int ph_lo, ph_hi;
 };

template <int CS_MODE  , int NMAP  >
__device__ __forceinline__ void p0_transpose_item(const float* W, int K, int N, int ld, bf16_t* WT, const float* rs, LAS float* scr, int item, int lane) {
    const int nblk = N / 64, kb = item / nblk, nb = item % nblk, k0 = 64 * kb, n0 = 64 * nb;
    const int lr = lane >> 4, lc = (lane & 15) * 4;
    f32x4 v[16];
#pragma unroll
    for (int i = 0; i < 16; ++i) v[i] = *(const f32x4*)(W + (size_t)(k0 + 4 * i + lr) * ld + n0 + lc);
#pragma unroll
    for (int i = 0; i < 16; ++i) {
        const int kk = 4 * i + lr; const float r = rs ? rs[k0 + kk] : 1.0f;
        scr[kk * 65 + lc + 0] = v[i][0] * r; scr[kk * 65 + lc + 1] = v[i][1] * r; scr[kk * 65 + lc + 2] = v[i][2] * r; scr[kk * 65 + lc + 3] = v[i][3] * r;
    }
    LDS_WAIT(); asm volatile("" ::: "memory");
    const int c = lane & 7;
#pragma unroll
    for (int j = 0; j < 8; ++j) {
        const int nl = (lane >> 3) + 8 * j, n = n0 + nl; const LAS float* sp = scr + (8 * c) * 65 + nl;
        float cs = 1.0f;
        if (CS_MODE == 2) { if (n >= 512 && n < 1024) cs = 0.08838834764831845f; }
        int nm = n;
        if (NMAP == 1) { nm = (n < 1024) ? (256 * (n >> 7) + (n & 127)) : (256 * ((n - 1024) >> 7) + 128 + ((n - 1024) & 127)); }
        u32x4 o; o.x = pk2(sp[0 * 65] * cs, sp[1 * 65] * cs); o.y = pk2(sp[2 * 65] * cs, sp[3 * 65] * cs); o.z = pk2(sp[4 * 65] * cs, sp[5 * 65] * cs); o.w = pk2(sp[6 * 65] * cs, sp[7 * 65] * cs);
        *(u32x4*)(WT + (size_t)nm * K + k0 + 8 * c) = o;
    }
    LDS_WAIT(); asm volatile("" ::: "memory");
}
struct QItem { int map, ld, n0; const float* W; const float* rs; signed char* Q; float* SW; };
#define P0_NMAP(MAP, n) ((MAP) == 1 ? (((n) < 1024) ? (256 * ((n) >> 7) + ((n) & 127)) : (256 * (((n) - 1024) >> 7) + 128 + (((n) - 1024) & 127))) : (n))
__device__ __forceinline__ void p0q_load(const Frame& F, const QItem& q, f32x4 (&v)[32], float (&rsv)[32]) {
    const int lr = F.lane >> 4, lc4 = F.lane & 15, w = F.wave;
    const unsigned voff = (unsigned)(((128 * w + 4 * lr) * q.ld + q.n0 + 4 * lc4) * 4);
    const float* rsl = q.rs + 128 * w + 4 * lr;
#pragma unroll
    for (int i = 0; i < 32; ++i) { const int kk = 16 * (i >> 2) + (i & 3); v[i] = *(const f32x4*)((const char*)q.W + (size_t)kk * q.ld * 4 + voff); rsv[i] = rsl[kk]; }
}
__device__ __forceinline__ void p0_quant_all(Frame& F, const float* w1, const float* w2, const float* w_in, const float* g_ffn, const float* g_mix) {
    LAS float* cm = (LAS float*)(F.lds + 8 * 16896);
    LAS unsigned* Tl = (LAS unsigned*)(F.lds + F.wave * 16896);
    const int lr = F.lane >> 4, lc4 = F.lane & 15, w = F.wave;
    constexpr int NIT = NEXP * 32 + 152 + NEXP * 16;
    auto item = [&](int it) { QItem q;
        if (it < NEXP * 32) { const int e = it >> 5; q.map = 1; q.W = w1 + (size_t)e * 1024 * 2048; q.ld = 2048; q.n0 = (it & 31) * 64; q.rs = g_ffn; q.Q = (signed char*)(F.ws + WS_W1) + (size_t)e * 2048 * 1024; q.SW = (float*)(F.ws + WS_SW1) + e * 2048; }
        else if (it < NEXP * 32 + 152) { q.map = 2; q.W = w_in; q.ld = PROJ_W; q.n0 = (it - NEXP * 32) * 64; q.rs = g_mix; q.Q = (signed char*)(F.ws + WS_WINQ); q.SW = (float*)(F.ws + WS_SWIN); }
        else { const int r2 = it - NEXP * 32 - 152, e = r2 >> 4; q.map = 0; q.W = w2 + (size_t)e * 1024 * 1024; q.ld = 1024; q.n0 = (r2 & 15) * 64; q.rs = nullptr; q.Q = (signed char*)(F.ws + WS_W2) + (size_t)e * 1024 * 1024; q.SW = (float*)(F.ws + WS_SW2) + e * 1024; }
        return q; };
    f32x4 v[32]; float rsv[32];
    int it = blockIdx.x;
    QItem q = item(it < NIT ? it : 0);
    if (q.rs == nullptr) q.rs = g_mix;
    if (it < NIT) p0q_load(F, q, v, rsv);
    while (it < NIT) {
        const int itn = it + F.G; const bool has = itn < NIT;
        QItem qn = item(has ? itn : it); if (qn.rs == nullptr) qn.rs = g_mix;
        const int MAP = q.map;
        f32x4 mx = {0.f, 0.f, 0.f, 0.f};
#pragma unroll
        for (int i = 0; i < 32; ++i) { if (MAP != 0) v[i] *= rsv[i]; mx[0] = fmaxf(mx[0], fabsf(v[i][0])); mx[1] = fmaxf(mx[1], fabsf(v[i][1])); mx[2] = fmaxf(mx[2], fabsf(v[i][2])); mx[3] = fmaxf(mx[3], fabsf(v[i][3])); }
#pragma unroll
        for (int c = 0; c < 4; ++c) { mx[c] = fmaxf(mx[c], __shfl_xor(mx[c], 16)); mx[c] = fmaxf(mx[c], __shfl_xor(mx[c], 32)); }
        __syncthreads();
        if (lr == 0) *(LAS f32x4*)(cm + w * 64 + 4 * lc4) = mx;
        __syncthreads();
#pragma unroll
        for (int ww = 0; ww < 8; ++ww) { const f32x4 o = *(const LAS f32x4*)(cm + ww * 64 + 4 * lc4); mx[0] = fmaxf(mx[0], o[0]); mx[1] = fmaxf(mx[1], o[1]); mx[2] = fmaxf(mx[2], o[2]); mx[3] = fmaxf(mx[3], o[3]); }
        f32x4 inv;
#pragma unroll
        for (int c = 0; c < 4; ++c) inv[c] = mx[c] > 0.f ? 127.0f / mx[c] : 0.f;
        if (w == 0 && lr == 0) {
#pragma unroll
            for (int c = 0; c < 4; ++c) { const int n = q.n0 + 4 * lc4 + c; float st = mx[c] * (1.0f / 127.0f); if (MAP == 2 && n < 1536) st *= 0.08838834764831845f * LOG2E; if (MAP == 2 && n >= 5120 && n < 5632) st *= 0.08838834764831845f; q.SW[P0_NMAP(MAP, n)] = st; }
        }
#pragma unroll
        for (int j = 0; j < 8; ++j)
#pragma unroll
            for (int c = 0; c < 4; ++c) {
                const int q0 = __float2int_rn(v[4 * j + 0][c] * inv[c]), q1 = __float2int_rn(v[4 * j + 1][c] * inv[c]), q2 = __float2int_rn(v[4 * j + 2][c] * inv[c]), q3 = __float2int_rn(v[4 * j + 3][c] * inv[c]);
                Tl[(4 * lc4 + c) * 33 + 4 * j + lr] = (unsigned)(q0 & 255) | ((unsigned)(q1 & 255) << 8) | ((unsigned)(q2 & 255) << 16) | ((unsigned)q3 << 24);
            }
        if (has) p0q_load(F, qn, v, rsv);
        LDS_WAIT(); asm volatile("" ::: "memory");
#pragma unroll
        for (int jj = 0; jj < 8; ++jj) {
            const int nl = (F.lane >> 3) + 8 * jj, ch = F.lane & 7, n = q.n0 + nl;
            u32x4 o; o.x = Tl[nl * 33 + 4 * ch + 0]; o.y = Tl[nl * 33 + 4 * ch + 1]; o.z = Tl[nl * 33 + 4 * ch + 2]; o.w = Tl[nl * 33 + 4 * ch + 3];
            *(u32x4*)(q.Q + (size_t)P0_NMAP(MAP, n) * 1024 + 128 * w + 16 * ch) = o;
        }
        LDS_WAIT(); asm volatile("" ::: "memory");
        q = qn; it = itn;
    }
    __syncthreads();
}
#undef P0_NMAP
__device__ __forceinline__ void p0_prologue(Frame& F) {
    LAS float* scr = (LAS float*)(F.lds + F.wave * 16896);
    const int gw = blockIdx.x * 8 + F.wave, NGW = F.G * 8;
    const float* x = F.in[0]; const float* g_mix = F.in[1]; const float* w_in = F.in[2]; const float* rel_bias = F.in[3];
    const float* w_att = F.in[4]; const float* w_ret = F.in[5]; const float* w_out = F.in[6]; const float* g_ffn = F.in[7];
    const float* w_router = F.in[8]; const float* w1 = F.in[10]; const float* w2 = F.in[12];
    constexpr int I_IN = 0, I_ATT = 8 * 16, I_RET = 16 * 16, I_OUT = 16 * 16, I_W1 = 16 * 32, I_W2 = 16 * 16;
    constexpr int NITEMS = I_IN + I_ATT + I_RET + I_OUT;
    for (int it = gw; it < NITEMS; it += NGW) {
        int r = it;
        if (r < I_ATT) { p0_transpose_item<0, 0>(w_att, 512, 1024, 1024, (bf16_t*)(F.ws + WS_WATT), nullptr, scr, r, F.lane); continue; } r -= I_ATT;
        if (r < I_RET) { p0_transpose_item<0, 0>(w_ret, 1024, 1024, 1024, (bf16_t*)(F.ws + WS_WRET), nullptr, scr, r, F.lane); continue; } r -= I_RET;
        p0_transpose_item<0, 0>(w_out, 1024, 1024, 1024, (bf16_t*)(F.ws + WS_WOUT), nullptr, scr, r, F.lane);
    }
    p0_quant_all(F, w1, w2, w_in, g_ffn, g_mix);
    unsigned* HBQ = (unsigned*)(F.dout + DO_HBQ); float* RS0 = (float*)(F.ws + WS_RS0);
    for (int m = 2 * gw; m < T_TOK; m += 2 * NGW) {
        const f32x4* xr = (const f32x4*)(x + (size_t)m * DM) + F.lane;
        f32x4 v[8]; float s0 = 0.f, s1 = 0.f;
#pragma unroll
        for (int j = 0; j < 8; ++j) v[j] = xr[64 * j];
#pragma unroll
        for (int j = 0; j < 4; ++j) { s0 += (v[j][0] * v[j][0] + v[j][1] * v[j][1]) + (v[j][2] * v[j][2] + v[j][3] * v[j][3]); s1 += (v[j + 4][0] * v[j + 4][0] + v[j + 4][1] * v[j + 4][1]) + (v[j + 4][2] * v[j + 4][2] + v[j + 4][3] * v[j + 4][3]); }
        const float r0 = 1.0f / sqrtf(wave_sum(s0) * (1.0f / DM) + NORM_EPS), r1 = 1.0f / sqrtf(wave_sum(s1) * (1.0f / DM) + NORM_EPS);
        float a0 = 0.f, a1 = 0.f;
#pragma unroll
        for (int j = 0; j < 4; ++j) { a0 = fmaxf(fmaxf(a0, fmaxf(fabsf(v[j][0]), fabsf(v[j][1]))), fmaxf(fabsf(v[j][2]), fabsf(v[j][3]))); a1 = fmaxf(fmaxf(a1, fmaxf(fabsf(v[j + 4][0]), fabsf(v[j + 4][1]))), fmaxf(fabsf(v[j + 4][2]), fabsf(v[j + 4][3]))); }
#pragma unroll
        for (int o = 1; o < 64; o <<= 1) { a0 = fmaxf(a0, __shfl_xor(a0, o)); a1 = fmaxf(a1, __shfl_xor(a1, o)); }
        const float q0i = a0 > 0.f ? 127.0f / a0 : 0.f, q1i = a1 > 0.f ? 127.0f / a1 : 0.f;
        if (F.lane == 0) { RS0[m] = r0 * a0 * (1.0f / 127.0f); RS0[m + 1] = r1 * a1 * (1.0f / 127.0f); }
        unsigned* oq = HBQ + (size_t)m * 256 + F.lane;
#pragma unroll
        for (int j = 0; j < 8; ++j) { const float qi = j < 4 ? q0i : q1i; const int b0 = __float2int_rn(v[j][0] * qi), b1 = __float2int_rn(v[j][1] * qi), b2 = __float2int_rn(v[j][2] * qi), b3 = __float2int_rn(v[j][3] * qi);
            oq[64 * j] = (unsigned)(b0 & 255) | ((unsigned)(b1 & 255) << 8) | ((unsigned)(b2 & 255) << 16) | ((unsigned)b3 << 24); }
    }
    const int gt = blockIdx.x * 512 + F.tid, NGT = F.G * 512;
    float* rope = (float*)(F.ws + WS_ROPE);
    for (int i = gt; i < SEQ * 64; i += NGT) {
        const int s = i >> 6, p = i & 63;
        const float inv = powf(10000.0f, -(float)(2 * p) / 128.0f);
        const float ang = (float)s * inv;
        float sn, cs; sincosf(ang, &sn, &cs);
        rope[i] = cs; rope[SEQ * 64 + i] = sn;
    }
    float* biasT = (float*)(F.ws + WS_BIAS);
    for (int i = gt; i < 12 * 132; i += NGT) {
        const int gh = i / 132, j = i % 132, g = gh >> 2;
        biasT[i] = (j <= 128) ? rel_bias[(int)T5B[g][j] * 12 + gh] * LOG2E : 0.0f;
    }
    float* wrl = (float*)(F.ws + WS_WRL);
    for (int i = gt; i < 1024 * 32; i += NGT) {
        const int c = i & 3, e = (i >> 2) & 31, g = (i >> 7) & 3, ii = i >> 9, k = 16 * ii + 4 * g + c;
        wrl[i] = g_ffn[k] * w_router[k * 32 + e];
    }
}

__device__ __forceinline__ void attn_phase(Frame& F, int g) {
    const int lg = (g == 0) ? 0 : (g == 1 ? 2 : 4), d = 1 << lg, nblk = (SEQ >> lg) >> 7;
    const bf16_t* AB = (const bf16_t*)(F.ws + DY_ATTBUF);
    bf16_t* ATT = (bf16_t*)(F.ws + DY_ATT);
    float* LSE = (float*)(F.ws + WS_LSE);
    const float* biasT = (const float*)(F.ws + WS_BIAS);
    LAS unsigned char* Kl = F.lds; LAS unsigned char* Vl = F.lds + 65536;
    LAS float* biasL = (LAS float*)(F.lds + LDS_AUX);
    const int lane = F.lane, w = F.wave, g4 = lane >> 4, l15 = lane & 15, q4 = l15 >> 2, p4 = lane & 3;
    u32x4 kreg[8], vreg[8]; bf16x8 qnx[4];
#define ATT_DECODE(it_, blk_, r_, slot_, b_) const int blk_ = (it_) % nblk, r_ = ((it_) / nblk) % d, slot_ = ((it_) / (nblk * d)) & 3, b_ = (it_) / (nblk * d * 4)
#define ATT_PREFETCH(it_) do { ATT_DECODE(it_, pblk, pr, pslot, pb); const int pm0 = pblk * 128, phead = 4 * g + pslot; \
        _Pragma("unroll") for (int j = 0; j < 8; ++j) { const int cidx = F.tid + 512 * j, kr = cidx >> 4, ch = cidx & 15; int step = pm0 - 128 + kr; step = step < 0 ? 0 : step; \
            const size_t rowoff = ((size_t)pb * SEQ + (size_t)step * d + pr) * N_ATT + phead * 128 + ch * 8; kreg[j] = *(const u32x4*)(AB + rowoff + 1536); vreg[j] = *(const u32x4*)(AB + rowoff + 3072); } \
        const size_t pq = (size_t)pb * SEQ + (size_t)(pm0 + 16 * w + l15) * d + pr; \
        _Pragma("unroll") for (int s = 0; s < 4; ++s) qnx[s] = *(const bf16x8*)(AB + pq * N_ATT + phead * 128 + 32 * s + 8 * g4); } while (0)
    if ((int)blockIdx.x < 2048) ATT_PREFETCH((int)blockIdx.x);
    for (int item = blockIdx.x; item < 2048; item += F.G) {
        ATT_DECODE(item, blk, r, slot, b);
        const int m0 = blk * 128, head = 4 * g + slot;
        __syncthreads();
        if (F.tid < 132) biasL[F.tid] = biasT[head * 132 + F.tid];
#pragma unroll
        for (int j = 0; j < 8; ++j) { const int cidx = F.tid + 512 * j, kr = cidx >> 4, ch = cidx & 15; *(LAS u32x4*)(Kl + off_b(kr, ch)) = kreg[j]; *(LAS u32x4*)(Vl + off_b(kr, ch)) = vreg[j]; }
        const int qstep = m0 + 16 * w + l15;
        const size_t qrow = (size_t)b * SEQ + (size_t)qstep * d + r;
        bf16x8 qf[4];
#pragma unroll
        for (int s = 0; s < 4; ++s) qf[s] = qnx[s];
        if (item + F.G < 2048) ATT_PREFETCH(item + F.G);
        __syncthreads();
        f32x4 sacc[9];
#pragma unroll
        for (int tt = 0; tt < 9; ++tt) {
            sacc[tt] = (f32x4){0.f, 0.f, 0.f, 0.f};
#pragma unroll
            for (int s = 0; s < 4; ++s) {
                const bf16x8 kf = *(const LAS bf16x8*)(Kl + off_b(16 * (w + tt) + l15, 4 * s + g4));
                sacc[tt] = __builtin_amdgcn_mfma_f32_16x16x32_bf16(kf, qf[s], sacc[tt], 0, 0, 0);
            }
        }
        const int kmin = 128 - m0;
        float mx = -1e30f;
#pragma unroll
        for (int tt = 0; tt < 9; ++tt)
#pragma unroll
            for (int rg = 0; rg < 4; ++rg) {
                const int dist = 128 + l15 - 16 * tt - 4 * g4 - rg, kidx = 16 * (w + tt) + 4 * g4 + rg;
                const bool valid = (dist >= 0) && (dist <= 128) && (kidx >= kmin);
                const int dc = dist < 0 ? 0 : (dist > 128 ? 128 : dist);
                const float v = valid ? sacc[tt][rg] + biasL[dc] : -1e30f;
                sacc[tt][rg] = v; mx = fmaxf(mx, v);
            }
        mx = fmaxf(mx, __shfl_xor(mx, 16)); mx = fmaxf(mx, __shfl_xor(mx, 32));
        float lsum = 0.f;
#pragma unroll
        for (int tt = 0; tt < 9; ++tt)
#pragma unroll
            for (int rg = 0; rg < 4; ++rg) { const float p = (sacc[tt][rg] > -1e29f) ? fast_exp2(sacc[tt][rg] - mx) : 0.f; sacc[tt][rg] = p; lsum += p; }
        lsum += __shfl_xor(lsum, 16); lsum += __shfl_xor(lsum, 32);
        f32x4 oacc[8];
#pragma unroll
        for (int dt = 0; dt < 8; ++dt) oacc[dt] = (f32x4){0.f, 0.f, 0.f, 0.f};
#pragma unroll
        for (int uu = 0; uu < 5; ++uu) {
            u32x4 pw; pw.x = pk2(sacc[2 * uu][0], sacc[2 * uu][1]); pw.y = pk2(sacc[2 * uu][2], sacc[2 * uu][3]);
            if (uu < 4) { pw.z = pk2(sacc[2 * uu + 1][0], sacc[2 * uu + 1][1]); pw.w = pk2(sacc[2 * uu + 1][2], sacc[2 * uu + 1][3]); } else { pw.z = 0u; pw.w = 0u; }
            const bf16x8 pf = __builtin_bit_cast(bf16x8, pw);
            const int r0 = 16 * (w + 2 * uu) + 4 * g4 + q4, r1 = (uu < 4) ? r0 + 16 : r0;
#pragma unroll
            for (int dt = 0; dt < 8; ++dt) {
                const s16x4 lo = tr_read(Vl + off_b(r0, 2 * dt + (p4 >> 1)) + 8 * (p4 & 1));
                const s16x4 hi = tr_read(Vl + off_b(r1, 2 * dt + (p4 >> 1)) + 8 * (p4 & 1));
                oacc[dt] = __builtin_amdgcn_mfma_f32_16x16x32_bf16(cat8(lo, hi), pf, oacc[dt], 0, 0, 0);
            }
        }
        const float rl = 1.0f / lsum;
        float lse = mx + __builtin_log2f(lsum);
        float wn = 1.0f, wp = 0.0f;
        bf16_t* orow = ATT + qrow * 512 + slot * 128 + 4 * g4;
        if (g > 0) {
            const float lp = LSE[qrow * 4 + slot];
            const float M = fmaxf(lp, lse); const float en = fast_exp2(lse - M), ep = fast_exp2(lp - M), tot = en + ep;
            wn = en / tot; wp = ep / tot; lse = M + __builtin_log2f(tot);
        }
        u32x2 pvv[8];
        if (g > 0) {
#pragma unroll
            for (int dt = 0; dt < 8; ++dt) pvv[dt] = *(const u32x2*)(orow + 16 * dt);
        }
#pragma unroll
        for (int dt = 0; dt < 8; ++dt) {
            f32x4 o = oacc[dt] * (rl * wn);
            if (g > 0) { const u32x2 pv = pvv[dt]; o[0] += wp * bflo(pv.x); o[1] += wp * bfhi(pv.x); o[2] += wp * bflo(pv.y); o[3] += wp * bfhi(pv.y); }
            u32x2 ow; ow.x = pk2(o[0], o[1]); ow.y = pk2(o[2], o[3]);
            *(u32x2*)(orow + 16 * dt) = ow;
        }
        if (g4 == 0) LSE[qrow * 4 + slot] = lse;
    }
#undef ATT_DECODE
#undef ATT_PREFETCH
}

__device__ __forceinline__ float ret_log2g(int h) { return __builtin_log2f(1.0f - __builtin_amdgcn_exp2f(-5.0f - (float)h)); }
__device__ __forceinline__ void ret_state_phase(Frame& F) {
    const bf16_t* RB = (const bf16_t*)(F.ws + DY_RETBUF);
    bf16_t* SR = (bf16_t*)(F.dout + DO_SR);
    const int lane = F.lane, w = F.wave, g4 = lane >> 4, l15 = lane & 15, q4 = l15 >> 2, p4 = lane & 3;
    for (int item = blockIdx.x; item < 256; item += F.G) {
        const int es = item & 3, h = (item >> 2) & 3, b = item >> 4;
        const float g128 = __builtin_amdgcn_exp2f(128.0f * ret_log2g(h));
        f32x4 acc[4];
#pragma unroll
        for (int et = 0; et < 4; ++et) acc[et] = (f32x4){0.f, 0.f, 0.f, 0.f};
        u32x4 kreg[4], vreg[2];
        const size_t rowbase = (size_t)b * SEQ;
#define RS_LOAD(n) do { \
            _Pragma("unroll") for (int j = 0; j < 4; ++j) { const int cidx = F.tid + 512 * j, jr = cidx >> 4, ch = cidx & 15; kreg[j] = *(const u32x4*)(RB + (rowbase + (n) * 128 + jr) * N_RET + 512 + h * 128 + ch * 8); } \
            _Pragma("unroll") for (int j = 0; j < 2; ++j) { const int cidx = F.tid + 512 * j, jr = cidx >> 3, ch = cidx & 7; vreg[j] = *(const u32x4*)(RB + (rowbase + (n) * 128 + jr) * N_RET + 1024 + h * 256 + es * 64 + ch * 8); } } while (0)
#define RS_STORE(buf) do { \
            _Pragma("unroll") for (int j = 0; j < 4; ++j) { const int cidx = F.tid + 512 * j, jr = cidx >> 4, ch = cidx & 15; *(LAS u32x4*)(F.lds + (buf) * 65536 + off_b(jr, ch)) = kreg[j]; } \
            _Pragma("unroll") for (int j = 0; j < 2; ++j) { const int cidx = F.tid + 512 * j, jr = cidx >> 3, ch = cidx & 7; *(LAS u32x4*)(F.lds + (buf) * 65536 + 32768 + off_b(jr, ch)) = vreg[j]; } } while (0)
        __syncthreads();
        RS_LOAD(0); RS_STORE(0);
        __syncthreads();
        for (int n = 0; n < 32; ++n) {
            const int buf = n & 1;
            if (n + 1 < 32) RS_LOAD(n + 1);
            bf16_t* srow = SR + ((size_t)((b * 4 + h) * 32 + n) * 256 + es * 64 + l15) * 128 + 16 * w + 4 * g4;
#pragma unroll
            for (int et = 0; et < 4; ++et) { u32x2 ow; ow.x = pk2(acc[et][0], acc[et][1]); ow.y = pk2(acc[et][2], acc[et][3]); *(u32x2*)(srow + (size_t)et * 16 * 128) = ow; }
            const LAS unsigned char* Kb = F.lds + buf * 65536; const LAS unsigned char* Vb = Kb + 32768;
#pragma unroll
            for (int ks = 0; ks < 4; ++ks) {
                const int j0 = 32 * ks + 8 * g4 + q4;
                const s16x4 klo = tr_read(Kb + off_b(j0, 2 * w + (p4 >> 1)) + 8 * (p4 & 1));
                const s16x4 khi = tr_read(Kb + off_b(j0 + 4, 2 * w + (p4 >> 1)) + 8 * (p4 & 1));
                const bf16x8 kf = cat8(klo, khi);
#pragma unroll
                for (int et = 0; et < 4; ++et) {
                    const s16x4 vlo = tr_read(Vb + off_b(j0, 2 * et + (p4 >> 1)) + 8 * (p4 & 1));
                    const s16x4 vhi = tr_read(Vb + off_b(j0 + 4, 2 * et + (p4 >> 1)) + 8 * (p4 & 1));
                    acc[et] = __builtin_amdgcn_mfma_f32_16x16x32_bf16(kf, cat8(vlo, vhi), acc[et], 0, 0, 0);
                }
            }
#pragma unroll
            for (int et = 0; et < 4; ++et) acc[et] *= g128;
            if (n + 1 < 32) RS_STORE(buf ^ 1);
            __syncthreads();
        }
#undef RS_LOAD
#undef RS_STORE
    }
}
__device__ __forceinline__ void ret_out_phase(Frame& F) {
    const bf16_t* RB = (const bf16_t*)(F.ws + DY_RETBUF);
    const bf16_t* SR = (const bf16_t*)(F.dout + DO_SR);
    bf16_t* RETN = (bf16_t*)(F.dout + DO_RETN);
    const int lane = F.lane, w = F.wave, g4 = lane >> 4, l15 = lane & 15, q4 = l15 >> 2, p4 = lane & 3;
    LAS unsigned char* Vl = F.lds;
    LAS unsigned char* Rl = F.lds + 65536;
    for (int item = blockIdx.x; item < 2048; item += F.G) {
        const int n = item & 31, h = (item >> 5) & 3, b = item >> 7;
        const size_t rowbase = (size_t)b * SEQ + n * 128;
        __syncthreads();
#pragma unroll
        for (int j = 0; j < 8; ++j) {
            const int cidx = F.tid + 512 * j;
            { const int jr = cidx >> 5, ch = cidx & 31; const u32x4 v = *(const u32x4*)(RB + (rowbase + jr) * N_RET + 1024 + h * 256 + ch * 8);
              *(LAS u32x4*)(Vl + (ch >> 4) * 32768 + off_b(jr, ch & 15)) = v; }
            { const int er = cidx >> 4, ch = cidx & 15; const u32x4 v = *(const u32x4*)(SR + ((size_t)((b * 4 + h) * 32 + n) * 256 + er) * 128 + ch * 8);
              *(LAS u32x4*)(Rl + off_b(er, ch)) = v; }
        }
        const size_t qrow = rowbase + 16 * w + l15;
        bf16x8 qf[4];
#pragma unroll
        for (int s = 0; s < 4; ++s) qf[s] = *(const bf16x8*)(RB + qrow * N_RET + h * 128 + 32 * s + 8 * g4);
        f32x4 sacc[8];
#pragma unroll
        for (int hb = 0; hb < 2; ++hb) {
            bf16x8 kf[4][4];
#pragma unroll
            for (int t4 = 0; t4 < 4; ++t4) { const int tt = 4 * hb + t4, tc = tt <= w ? tt : w;
#pragma unroll
                for (int s = 0; s < 4; ++s) kf[t4][s] = *(const bf16x8*)(RB + (rowbase + 16 * tc + l15) * N_RET + 512 + h * 128 + 32 * s + 8 * g4); }
#pragma unroll
            for (int t4 = 0; t4 < 4; ++t4) { const int tt = 4 * hb + t4;
                f32x4 a = (f32x4){0.f, 0.f, 0.f, 0.f};
#pragma unroll
                for (int s = 0; s < 4; ++s) a = __builtin_amdgcn_mfma_f32_16x16x32_bf16(kf[t4][s], qf[s], a, 0, 0, 0);
                if (tt > w) a = (f32x4){0.f, 0.f, 0.f, 0.f};
                if (tt == w) {
#pragma unroll
                    for (int rg = 0; rg < 4; ++rg) if (4 * g4 + rg > l15) a[rg] = 0.f;
                }
                sacc[tt] = a;
            }
        }
        __syncthreads();
        f32x4 oacc[16];
#pragma unroll
        for (int et = 0; et < 16; ++et) oacc[et] = (f32x4){0.f, 0.f, 0.f, 0.f};
#pragma unroll
        for (int uu = 0; uu < 4; ++uu) {
            if (2 * uu <= w) {
                u32x4 pw; pw.x = pk2(sacc[2 * uu][0], sacc[2 * uu][1]); pw.y = pk2(sacc[2 * uu][2], sacc[2 * uu][3]);
                pw.z = pk2(sacc[2 * uu + 1][0], sacc[2 * uu + 1][1]); pw.w = pk2(sacc[2 * uu + 1][2], sacc[2 * uu + 1][3]);
                const bf16x8 pf = __builtin_bit_cast(bf16x8, pw);
                const int r0 = 32 * uu + 4 * g4 + q4, r1 = r0 + 16;
#pragma unroll
                for (int et = 0; et < 16; ++et) {
                    const LAS unsigned char* vb = Vl + (et >> 3) * 32768;
                    const s16x4 lo = tr_read(vb + off_b(r0, 2 * (et & 7) + (p4 >> 1)) + 8 * (p4 & 1));
                    const s16x4 hi = tr_read(vb + off_b(r1, 2 * (et & 7) + (p4 >> 1)) + 8 * (p4 & 1));
                    oacc[et] = __builtin_amdgcn_mfma_f32_16x16x32_bf16(cat8(lo, hi), pf, oacc[et], 0, 0, 0);
                }
            }
        }
#pragma unroll
        for (int et = 0; et < 16; ++et)
#pragma unroll
            for (int s = 0; s < 4; ++s) {
                const bf16x8 rf = *(const LAS bf16x8*)(Rl + off_b(16 * et + l15, 4 * s + g4));
                oacc[et] = __builtin_amdgcn_mfma_f32_16x16x32_bf16(rf, qf[s], oacc[et], 0, 0, 0);
            }
        float sm = 0.f;
#pragma unroll
        for (int et = 0; et < 16; ++et) sm += (oacc[et][0] + oacc[et][1]) + (oacc[et][2] + oacc[et][3]);
        sm += __shfl_xor(sm, 16); sm += __shfl_xor(sm, 32);
        const float mean = sm * (1.0f / 256.0f);
        float sq = 0.f;
#pragma unroll
        for (int et = 0; et < 16; ++et) { const f32x4 dv = oacc[et] - mean; sq += (dv[0] * dv[0] + dv[1] * dv[1]) + (dv[2] * dv[2] + dv[3] * dv[3]); }
        sq += __shfl_xor(sq, 16); sq += __shfl_xor(sq, 32);
        const float rstd = 1.0f / sqrtf(sq * (1.0f / 256.0f) + NORM_EPS);
        const bf16_t* grow = RB + qrow * N_RET + 2048 + h * 256 + 4 * g4;
        bf16_t* orow = RETN + qrow * 1024 + h * 256 + 4 * g4;
        u32x2 gwv[16];
#pragma unroll
        for (int et = 0; et < 16; ++et) gwv[et] = *(const u32x2*)(grow + 16 * et);
#pragma unroll
        for (int et = 0; et < 16; ++et) {
            const u32x2 gw = gwv[et];
            const f32x4 y = (oacc[et] - mean) * rstd;
            u32x2 ow; ow.x = pk2(y[0] * bflo(gw.x), y[1] * bfhi(gw.x)); ow.y = pk2(y[2] * bflo(gw.y), y[3] * bfhi(gw.y));
            *(u32x2*)(orow + 16 * et) = ow;
        }
    }
}

__device__ __forceinline__ void router_phase(Frame& F) {
    const float* X1 = (const float*)F.dout;
    const float* wrl = (const float*)(F.ws + WS_WRL);
    const float* b_router = F.in[9];
    float* RSTD = (float*)(F.ws + WS_RSTD);
    unsigned* X1Q = (unsigned*)(F.ws + DY_X1B);
    int* asg_e = (int*)(F.ws + WS_ASG); float* asg_w = (float*)(F.ws + WS_ASG + 1 * MiB); int* asg_idx = (int*)(F.ws + WS_ASG + 2 * MiB);
    unsigned* gcnt = (unsigned*)(F.ws + WS_CTL) + CW_GCNT;
    LAS f32x4* WL = (LAS f32x4*)F.lds;
    LAS unsigned* hist = (LAS unsigned*)(F.lds + LDS_AUX);
    LAS unsigned* basel = hist + 32;
    LAS unsigned char* lds_e = (LAS unsigned char*)(F.lds + LDS_AUX + 256);
    LAS unsigned short* lds_rank = (LAS unsigned short*)(F.lds + LDS_AUX + 1280);
    const int lane = F.lane, w = F.wave, g4 = lane >> 4, l15 = lane & 15;
    __syncthreads();
    for (int i = F.tid; i < 8192; i += 512) WL[i] = ((const f32x4*)wrl)[i];
    if (F.tid < 32) hist[F.tid] = 0u;
    __syncthreads();
    for (int tb = blockIdx.x; tb < 256; tb += F.G) {
        const int half = tb >> 8;
#pragma unroll 1
        for (int it = 0; it < 2; ++it) {
            const int rg = 2 * w + it, row0 = tb * 256 + rg * 16;
            const float* xr = X1 + (size_t)(row0 + l15) * DM + 4 * g4;
            f32x4 acc0 = {0.f, 0.f, 0.f, 0.f}, acc1 = {0.f, 0.f, 0.f, 0.f}; float ss = 0.f, amax = 0.f;
#pragma unroll 1
            for (int ib = 0; ib < 8; ++ib) {
                f32x4 xv[8];
#pragma unroll
                for (int ii = 0; ii < 8; ++ii) xv[ii] = *(const f32x4*)(xr + 16 * (8 * ib + ii));
#pragma unroll
                for (int ii = 0; ii < 8; ++ii) {
                    const int i = 8 * ib + ii;
                    const f32x4 w0 = WL[(i * 4 + g4) * 32 + l15], w1 = WL[(i * 4 + g4) * 32 + 16 + l15];
#pragma unroll
                    for (int c = 0; c < 4; ++c) {
                        ss += xv[ii][c] * xv[ii][c]; amax = fmaxf(amax, fabsf(xv[ii][c]));
                        acc0 = __builtin_amdgcn_mfma_f32_16x16x4f32(xv[ii][c], w0[c], acc0, 0, 0, 0);
                        acc1 = __builtin_amdgcn_mfma_f32_16x16x4f32(xv[ii][c], w1[c], acc1, 0, 0, 0);
                    }
                }
            }
            ss += __shfl_xor(ss, 16); ss += __shfl_xor(ss, 32);
            const float rs = 1.0f / sqrtf(ss * (1.0f / DM) + NORM_EPS);
            amax = fmaxf(amax, __shfl_xor(amax, 16)); amax = fmaxf(amax, __shfl_xor(amax, 32));
            const float qinv = amax > 0.f ? 127.0f / amax : 0.f;
            if (lane < 16) RSTD[row0 + lane] = rs * amax * (1.0f / 127.0f);
#pragma unroll 1
            for (int ib = 0; ib < 8; ++ib) {
                f32x4 xq[8];
#pragma unroll
                for (int ii = 0; ii < 8; ++ii) xq[ii] = *(const f32x4*)(xr + 16 * (8 * ib + ii));
#pragma unroll
                for (int ii = 0; ii < 8; ++ii) {
                    const int q0 = __float2int_rn(xq[ii][0] * qinv), q1 = __float2int_rn(xq[ii][1] * qinv), q2 = __float2int_rn(xq[ii][2] * qinv), q3 = __float2int_rn(xq[ii][3] * qinv);
                    X1Q[(size_t)(row0 + l15) * 256 + 4 * (8 * ib + ii) + g4] = (unsigned)(q0 & 255) | ((unsigned)(q1 & 255) << 8) | ((unsigned)(q2 & 255) << 16) | ((unsigned)q3 << 24);
                }
            }
            const float b0 = b_router[l15], b1 = b_router[16 + l15];
#pragma unroll
            for (int rgi = 0; rgi < 4; ++rgi) {
                const float rr = __shfl(rs, 4 * g4 + rgi);
                float v0 = acc0[rgi] * rr + b0, v1 = acc1[rgi] * rr + b1;
                float pv[4]; int pi[4];
#pragma unroll
                for (int pk = 0; pk < 4; ++pk) {
                    float bv; int bi;
                    if (v0 >= v1) { bv = v0; bi = l15; } else { bv = v1; bi = 16 + l15; }
#pragma unroll
                    for (int o = 1; o < 16; o <<= 1) {
                        const float ov = __shfl_xor(bv, o); const int oi = __shfl_xor(bi, o);
                        if (ov > bv || (ov == bv && oi < bi)) { bv = ov; bi = oi; }
                    }
                    pv[pk] = bv; pi[pk] = bi;
                    if (bi == l15) v0 = -3.0e38f;
                    if (bi == 16 + l15) v1 = -3.0e38f;
                }
                if (l15 == 0) {
                    const float e1 = __expf(pv[1] - pv[0]), e2 = __expf(pv[2] - pv[0]), e3 = __expf(pv[3] - pv[0]);
                    const float inv = 1.0f / (1.0f + e1 + e2 + e3);
                    const float gt[4] = {inv, e1 * inv, e2 * inv, e3 * inv};
                    const int tl = rg * 16 + 4 * g4 + rgi, tok = tb * 256 + tl;
#pragma unroll
                    for (int pk = 0; pk < 4; ++pk) {
                        const unsigned rk = atomicAdd((unsigned*)&hist[pi[pk]], 1u);
                        lds_e[tl * 4 + pk] = (unsigned char)pi[pk]; lds_rank[tl * 4 + pk] = (unsigned short)rk;
                        asg_w[tok * 4 + pk] = gt[pk];
                    }
                }
            }
        }
        __syncthreads();
        if (F.tid < 32) { basel[F.tid] = atomicAdd(&gcnt[half * 32 + F.tid], hist[F.tid]); }
        __syncthreads();
        for (int a = F.tid; a < 1024; a += 512) {
            const int e = lds_e[a];
            asg_e[tb * 1024 + a] = e; asg_idx[tb * 1024 + a] = (int)(basel[e] + lds_rank[a]);
        }
        __syncthreads();
        if (F.tid < 32) hist[F.tid] = 0u;
        __syncthreads();
    }
}
__device__ __forceinline__ void scatter_phase(Frame& F) {
    const unsigned* gcnt = (const unsigned*)(F.ws + WS_CTL) + CW_GCNT;
    const float* RSTD = (const float*)(F.ws + WS_RSTD);
    const int* asg_e = (const int*)(F.ws + WS_ASG); const float* asg_w = (const float*)(F.ws + WS_ASG + 1 * MiB); const int* asg_idx = (const int*)(F.ws + WS_ASG + 2 * MiB);
    int* asg_pos = (int*)(F.ws + WS_ASG + 3 * MiB);
    int* tile_expert = (int*)(F.ws + WS_TILE);
    LAS int* seg = (LAS int*)(F.lds + LDS_AUX);
    LAS int* cntl = seg + 64;
    __syncthreads();
    if (F.tid < 2) {
        int run = 0;
        for (int e = 0; e < 32; ++e) { const int c = (int)__hip_atomic_load(&gcnt[F.tid * 32 + e], __ATOMIC_RELAXED, __HIP_MEMORY_SCOPE_AGENT); seg[F.tid * 32 + e] = run; cntl[F.tid * 32 + e] = c; run += (c + 255) & ~255; }
        if (blockIdx.x == 0) tile_expert[2 * HALF_TILES + F.tid] = run >> 8;
    }
    __syncthreads();
    const int gt = blockIdx.x * 512 + F.tid, NGT = F.G * 512;
    for (int a = gt; a < T_TOK * 4; a += NGT) {
        const int tok = a >> 2, half = tok >> 16, e = asg_e[a];
        const int pos = seg[half * 32 + e] + asg_idx[a];
        int* tokS = (int*)(F.ws + WS_SORT + (size_t)half * 3 * HALF_ROWS * 4); float* wS = (float*)(tokS + HALF_ROWS); float* rS = wS + HALF_ROWS;
        tokS[pos] = tok; wS[pos] = asg_w[a]; rS[pos] = RSTD[tok]; asg_pos[a] = pos;
    }
    for (int j = blockIdx.x; j < 32; j += F.G) {
        const int half = j >> 5, e = j & 31, s0 = seg[j], c = cntl[j], pe = (c + 255) & ~255;
        int* tokS = (int*)(F.ws + WS_SORT + (size_t)half * 3 * HALF_ROWS * 4); float* wS = (float*)(tokS + HALF_ROWS); float* rS = wS + HALF_ROWS;
        for (int i = c + F.tid; i < pe; i += 512) { tokS[s0 + i] = half * HALF_TOK; wS[s0 + i] = 0.f; rS[s0 + i] = 0.f; }
        for (int t = F.tid; t < (pe >> 8); t += 512) tile_expert[half * HALF_TILES + (s0 >> 8) + t] = e;
    }
}
__device__ __forceinline__ void final_phase(Frame& F, int half) {
    float* X1 = (float*)F.dout;
    const bf16_t* Y = (const bf16_t*)(F.ws + DY_Y);
    const int* asg_pos = (const int*)(F.ws + WS_ASG + 3 * MiB);
    const float* gfin = F.in[14];
    const int gw = blockIdx.x * 8 + F.wave, NGW = F.G * 8;
    for (int m0 = half * HALF_TOK + 2 * gw; m0 < (half + 1) * HALF_TOK; m0 += 2 * NGW) {
        int pos[2][4]; f32x4 v[2][4]; u32x2 yw[2][4][4];
#pragma unroll
        for (int r = 0; r < 2; ++r)
#pragma unroll
            for (int k = 0; k < 4; ++k) pos[r][k] = asg_pos[(m0 + r) * 4 + k];
#pragma unroll
        for (int r = 0; r < 2; ++r)
#pragma unroll
            for (int j = 0; j < 4; ++j) {
                v[r][j] = ((const f32x4*)(X1 + (size_t)(m0 + r) * DM) + F.lane)[64 * j];
#pragma unroll
                for (int k = 0; k < 4; ++k) yw[r][j][k] = *((const u32x2*)(Y + (size_t)pos[r][k] * DM) + F.lane + 64 * j);
            }
        float s[2] = {0.f, 0.f};
#pragma unroll
        for (int r = 0; r < 2; ++r)
#pragma unroll
            for (int j = 0; j < 4; ++j) {
#pragma unroll
                for (int k = 0; k < 4; ++k) { v[r][j][0] += bflo(yw[r][j][k].x); v[r][j][1] += bfhi(yw[r][j][k].x); v[r][j][2] += bflo(yw[r][j][k].y); v[r][j][3] += bfhi(yw[r][j][k].y); }
                s[r] += (v[r][j][0] * v[r][j][0] + v[r][j][1] * v[r][j][1]) + (v[r][j][2] * v[r][j][2] + v[r][j][3] * v[r][j][3]);
            }
#pragma unroll
        for (int r = 0; r < 2; ++r) {
            const float rstd = 1.0f / sqrtf(wave_sum(s[r]) * (1.0f / DM) + NORM_EPS);
            f32x4* xr = (f32x4*)(X1 + (size_t)(m0 + r) * DM) + F.lane;
#pragma unroll
            for (int j = 0; j < 4; ++j) { const f32x4 gg = *((const f32x4*)gfin + F.lane + 64 * j); xr[64 * j] = v[r][j] * rstd * gg; }
        }
    }
}

constexpr int N_PHASES = 15;
__global__ void __launch_bounds__(512, 2) mk_fwd(Args args) {
    extern __shared__ __attribute__((aligned(16))) unsigned char lds_raw[];
    Frame F;
    F.lds = (LAS unsigned char*)lds_raw;
    F.tid = threadIdx.x; F.lane = F.tid & 63; F.wave = __builtin_amdgcn_readfirstlane(F.tid >> 6); F.G = gridDim.x;
    F.ws = args.ws; F.dout = (unsigned char*)args.out;
#pragma unroll
    for (int i = 0; i < 15; ++i) F.in[i] = args.in[i];
    volatile LAS unsigned* MISC = (volatile LAS unsigned*)(F.lds + LDS_MISC);
    if (F.tid < 64) MISC[F.tid] = 0u;
    __syncthreads();
    XcdBarrier bar; bar.bar = (unsigned*)(F.ws + WS_CTL) + CW_BAR; bar.x = 0; bar.st = nullptr;
    if (!MK_PER_PHASE) bar = xcd_barrier_post((unsigned*)(F.ws + WS_CTL) + CW_BAR, MISC + 8);
    const int lo = args.ph_lo, hi = args.ph_hi;
#define IN(k) (lo <= (k) && (k) < hi)
#define SEAM(k) do { if (IN(k) && IN((k) + 1)) xcd_barrier(bar); } while (0)
    using namespace pg8;
    const float* rope = (const float*)(F.ws + WS_ROPE);
    const int c = (int)blockIdx.x;

    if (IN(0)) { p0_prologue(F); } SEAM(0);
    if (IN(1)) {
        SchedDense S{T_TOK / 256, N_ATT / 256, F.G, c, 512, (const char*)(F.ws + WS_WINQ)};
        EpiProj<0> E{(bf16_t*)(F.ws + DY_ATTBUF), N_ATT, rope, (const float*)(F.ws + WS_RS0), (const float*)(F.ws + WS_SWIN)};
        gemm_phase<EpiProj<0>, SchedDense, true>(F.lds, (const char*)(F.dout + DO_HBQ), S, E);
    } SEAM(1);
    if (IN(2)) { attn_phase(F, 0); } SEAM(2);
    if (IN(3)) { attn_phase(F, 1); } SEAM(3);
    if (IN(4)) { attn_phase(F, 2); } SEAM(4);
    if (IN(5)) {
        { SchedDense S{T_TOK / 256, N_GATE / 256, F.G, c, 512, (const char*)(F.ws + WS_WINQ) + (size_t)7680 * 1024};
          EpiProj<0> E{(bf16_t*)(F.ws + DY_GATEBUF), N_GATE, rope, (const float*)(F.ws + WS_RS0), (const float*)(F.ws + WS_SWIN) + 7680};
          gemm_phase<EpiProj<0>, SchedDense, true>(F.lds, (const char*)(F.dout + DO_HBQ), S, E); }
        { SchedDense S{T_TOK / 256, N_RET / 256, F.G, c, 512, (const char*)(F.ws + WS_WINQ) + (size_t)4608 * 1024};
          EpiProj<2> E{(bf16_t*)(F.ws + DY_RETBUF), N_RET, rope, (const float*)(F.ws + WS_RS0), (const float*)(F.ws + WS_SWIN) + 4608};
          gemm_phase<EpiProj<2>, SchedDense, true>(F.lds, (const char*)(F.dout + DO_HBQ), S, E); }
    } SEAM(5);
    if (IN(6)) { ret_state_phase(F); } SEAM(6);
    if (IN(7)) { ret_out_phase(F); } SEAM(7);
    if (IN(8)) {
        { SchedDense S{T_TOK / 256, 4, F.G, c, 512, (const char*)(F.ws + WS_WATT)};
          EpiM1 E{(bf16_t*)(F.ws + DY_M1), (const bf16_t*)(F.ws + DY_GATEBUF)};
          gemm_phase(F.lds, (const char*)(F.ws + DY_ATT), S, E); }
        VM_WAIT(); __syncthreads();
        { SchedDense S{T_TOK / 256, 4, F.G, c, 1024, (const char*)(F.ws + WS_WRET)};
          EpiMerge E{(bf16_t*)(F.ws + DY_MERGED), (const bf16_t*)(F.ws + DY_GATEBUF), (const bf16_t*)(F.ws + DY_M1)};
          gemm_phase(F.lds, (const char*)(F.dout + DO_RETN), S, E); }
    } SEAM(8);
    if (IN(9)) {
        SchedDense S{T_TOK / 256, 4, F.G, c, 1024, (const char*)(F.ws + WS_WOUT)};
        EpiX1 E{F.in[0], (float*)F.dout};
        gemm_phase(F.lds, (const char*)(F.ws + DY_MERGED), S, E);
    } SEAM(9);
    if (IN(10)) { router_phase(F); } SEAM(10);
    if (IN(11)) { scatter_phase(F); } SEAM(11);
#define MOE_UP(half) do { \
        const int* tileE = (const int*)(F.ws + WS_TILE) + (half) * HALF_TILES; const int ntl = __builtin_amdgcn_readfirstlane(((const int*)(F.ws + WS_TILE))[2 * HALF_TILES + (half)]); \
        const int* tokS = (const int*)(F.ws + WS_SORT + (size_t)(half) * 3 * HALF_ROWS * 4); \
        SchedMoE S{ntl, 8, F.G, c, 512, (const char*)(F.ws + WS_W1), (size_t)2048 * 1024, tileE, tokS}; \
        EpiSwiglu E{(bf16_t*)(F.ws + DY_ACT), F.in[11], (const float*)(tokS + 2 * HALF_ROWS), (const float*)(F.ws + WS_SW1)}; \
        gemm_phase<EpiSwiglu, SchedMoE, true>(F.lds, (const char*)(F.ws + DY_X1B), S, E); } while (0)
#define MOE_DOWN(half) do { \
        const int* tileE = (const int*)(F.ws + WS_TILE) + (half) * HALF_TILES; const int ntl = __builtin_amdgcn_readfirstlane(((const int*)(F.ws + WS_TILE))[2 * HALF_TILES + (half)]); \
        const int* tokS = (const int*)(F.ws + WS_SORT + (size_t)(half) * 3 * HALF_ROWS * 4); \
        SchedMoE S{ntl, 4, F.G, c, 512, (const char*)(F.ws + WS_W2), (size_t)1024 * 1024, tileE, nullptr}; \
        EpiDown E{(bf16_t*)(F.ws + DY_Y), F.in[13], (const float*)(tokS + HALF_ROWS), (const float*)(F.ws + WS_SW2)}; \
        gemm_phase<EpiDown, SchedMoE, true>(F.lds, (const char*)(F.ws + DY_ACT), S, E); } while (0)
    if (IN(12)) { MOE_UP(0); } SEAM(12);
    if (IN(13)) { MOE_DOWN(0); } SEAM(13);
    if (IN(14)) { final_phase(F, 0); }
#undef IN
#undef SEAM
}


extern "C" void kernel_launch(void* const* d_in, const int* in_sizes, int n_in, void* d_out, int out_size, void* d_ws, size_t ws_size, hipStream_t stream) {
    static int grid = 0;
    if (grid == 0) {
        if (n_in != 15 || out_size != T_TOK * DM || ws_size < WS_END) { fprintf(stderr, "kernel_launch: unexpected shapes (n_in %d out %d ws %zu)\n", n_in, out_size, ws_size); grid = -1; return; }
        int dev = 0, cus = 0, per_cu = 0;
        if (hipGetDevice(&dev) != hipSuccess || hipDeviceGetAttribute(&cus, hipDeviceAttributeMultiprocessorCount, dev) != hipSuccess) { grid = -1; return; }
        if (hipFuncSetAttribute((const void*)mk_fwd, hipFuncAttributeMaxDynamicSharedMemorySize, LDS_BYTES) != hipSuccess) { fprintf(stderr, "kernel_launch: hipFuncSetAttribute failed\n"); grid = -1; return; }
        if (hipOccupancyMaxActiveBlocksPerMultiprocessor(&per_cu, (const void*)mk_fwd, 512, LDS_BYTES) != hipSuccess || per_cu < 1) { fprintf(stderr, "kernel_launch: occupancy query says %d\n", per_cu); }
        (void)hipGetLastError();
        grid = cus;
    }
    if (grid < 0) return;
    (void)hipMemsetAsync((char*)d_ws + WS_CTL, 0, CTL_BYTES, stream);
    Args a{};
    for (int i = 0; i < 15; ++i) a.in[i] = (const float*)d_in[i];
    a.out = (float*)d_out; a.ws = (unsigned char*)d_ws;
#if MK_PER_PHASE
    for (int p = 0; p < N_PHASES; ++p) { a.ph_lo = p; a.ph_hi = p + 1; hipLaunchKernelGGL(mk_fwd, dim3(grid), dim3(512), LDS_BYTES, stream, a); }
#else
    a.ph_lo = 0; a.ph_hi = N_PHASES;
    hipLaunchKernelGGL(mk_fwd, dim3(grid), dim3(512), LDS_BYTES, stream, a);
#endif
}
```

```cpp
#include <hip/hip_runtime.h>
#include <cstdio>
#include <cstdint>

#ifndef MK_PER_PHASE
#define MK_PER_PHASE 0
#endif

#define GAS __attribute__((address_space(1)))
#define LAS __attribute__((address_space(3)))
typedef unsigned short bf16_t;
typedef short bf16x8 __attribute__((ext_vector_type(8)));
typedef short s16x4 __attribute__((ext_vector_type(4)));
typedef float f32x4 __attribute__((ext_vector_type(4)));
typedef float f32x2 __attribute__((ext_vector_type(2)));
typedef unsigned u32x4 __attribute__((ext_vector_type(4)));
typedef unsigned u32x2 __attribute__((ext_vector_type(2)));
typedef int i32x4 __attribute__((ext_vector_type(4)));

constexpr int T_TOK = 65536, DM = 1024, SEQ = 4096, NB = 16;
constexpr int N_ATT = 4608, N_RET = 3072, N_GATE = 2048, PROJ_W = 9728;
constexpr int NEXP = 32, TOPK = 4, DEXP = 1024;
constexpr int HALF_TOK = 65536, HALF_ROWS = 270336, HALF_TILES = 1056;
constexpr float NORM_EPS = 1e-5f;
constexpr float LOG2E = 1.4426950408889634f;

constexpr size_t MiB = 1u << 20;
constexpr size_t WS_CTL = 0, CTL_BYTES = 1 * MiB;
constexpr size_t WS_ROPE = 1 * MiB;
constexpr size_t WS_BIAS = 3 * MiB;
constexpr size_t WS_WRL = 3 * MiB + 65536;
constexpr size_t WS_RSTD = 4 * MiB;
constexpr size_t WS_ASG = 5 * MiB;
constexpr size_t WS_SORT = 9 * MiB;
constexpr size_t WS_TILE = 13 * MiB;
constexpr size_t WS_LSE = 14 * MiB;
constexpr size_t WS_WATT = 16 * MiB;
constexpr size_t WS_WRET = 17 * MiB;
constexpr size_t WS_WOUT = 19 * MiB;
constexpr size_t WS_STATS = 21 * MiB;
constexpr size_t WS_W1 = 40 * MiB;
constexpr size_t WS_SW1 = 104 * MiB;
constexpr size_t WS_WINQ = 112 * MiB;
constexpr size_t WS_SWIN = 124 * MiB;
constexpr size_t WS_RS0 = 4 * MiB + 512 * 1024;
constexpr size_t WS_W2 = 168 * MiB;
constexpr size_t WS_SW2 = 125 * MiB;
constexpr float ACT_STEP = 12.0f / 127.0f;
constexpr size_t WS_DYN = 232 * MiB;
constexpr size_t DY_ATTBUF = WS_DYN;
constexpr size_t DY_ATT = WS_DYN + 720 * MiB;
constexpr size_t DY_RETBUF = WS_DYN;
constexpr size_t DY_GATEBUF = WS_DYN + 384 * MiB;
constexpr size_t DY_M1 = WS_DYN;
constexpr size_t DY_MERGED = WS_DYN + 128 * MiB;
constexpr size_t DY_X1B = 200 * MiB;
constexpr size_t DY_ACT = 728 * MiB;
constexpr size_t DY_Y = 200 * MiB;
constexpr size_t DY_YS = 464 * MiB;
constexpr size_t WS_END = WS_DYN + 792 * MiB;
static_assert(DY_Y + (size_t)HALF_ROWS * 2048 <= DY_ACT && DY_ACT + (size_t)HALF_ROWS * 1024 <= WS_END && WS_W2 + (size_t)NEXP * 1024 * 1024 <= DY_Y, "ws map");
static_assert(DY_ATTBUF + (size_t)T_TOK * N_ATT * 2 <= DY_ATT, "ws map");
constexpr size_t DO_HB = 0, DO_SR = 0, DO_RETN = 128 * MiB, DO_HBQ = 128 * MiB;

constexpr int CW_BAR = 1024;
constexpr int CW_GCNT = 8192;

constexpr int LDS_MAIN = 131072;
constexpr int LDS_AUX = LDS_MAIN;
constexpr int LDS_MISC = LDS_MAIN + 7168;
constexpr int LDS_BYTES = LDS_MAIN + 8192;

__device__ __forceinline__ float bf2f(unsigned short b) { return __uint_as_float(((unsigned)b) << 16); }
typedef __bf16 bf16x2_t __attribute__((ext_vector_type(2)));
__device__ __forceinline__ unsigned pk2(float lo, float hi) { const f32x2 v = {lo, hi}; const bf16x2_t b = __builtin_convertvector(v, bf16x2_t); return __builtin_bit_cast(unsigned, b); }
__device__ __forceinline__ float bflo(unsigned w) { return __uint_as_float(w << 16); }
__device__ __forceinline__ float bfhi(unsigned w) { return __uint_as_float(w & 0xffff0000u); }
__device__ __forceinline__ float fast_exp2(float x) { return __builtin_amdgcn_exp2f(x); }
__device__ __forceinline__ float fast_rcp(float x) { return __builtin_amdgcn_rcpf(x); }
__device__ __forceinline__ float sigmoidf_(float x) { return fast_rcp(1.0f + fast_exp2(-x * LOG2E)); }
__device__ __forceinline__ float xr_max(float x) {
    auto r = __builtin_amdgcn_permlane16_swap(__float_as_uint(x), __float_as_uint(x), false, false); x = fmaxf(__uint_as_float(r[0]), __uint_as_float(r[1]));
    auto q = __builtin_amdgcn_permlane32_swap(__float_as_uint(x), __float_as_uint(x), false, false); return fmaxf(__uint_as_float(q[0]), __uint_as_float(q[1]));
}
__device__ __forceinline__ float xr_sum(float x) {
    auto r = __builtin_amdgcn_permlane16_swap(__float_as_uint(x), __float_as_uint(x), false, false); x = __uint_as_float(r[0]) + __uint_as_float(r[1]);
    auto q = __builtin_amdgcn_permlane32_swap(__float_as_uint(x), __float_as_uint(x), false, false); return __uint_as_float(q[0]) + __uint_as_float(q[1]);
}
__device__ __forceinline__ unsigned pack_lo4(unsigned f0, unsigned f1, unsigned f2, unsigned f3) {
    return __builtin_amdgcn_perm(f1, f0, 0x0c0c0400u) | __builtin_amdgcn_perm(f3, f2, 0x04000c0cu);
}
__device__ __forceinline__ float wave_sum(float v) {
#pragma unroll
    for (int o = 1; o < 64; o <<= 1) v += __shfl_xor(v, o);
    return v;
}
#define LDS_WAIT() asm volatile("s_waitcnt lgkmcnt(0)" ::: "memory")
#define VM_WAIT() asm volatile("s_waitcnt vmcnt(0)" ::: "memory")

__device__ __forceinline__ unsigned off_b(unsigned row, unsigned ch) { return 256u * row + 16u * (ch ^ (((row & 3u) << 2) | ((row >> 2) & 3u))); }
__device__ __forceinline__ s16x4 tr_read(const LAS unsigned char* p) { return __builtin_amdgcn_ds_read_tr16_b64_v4i16((LAS s16x4*)p); }
__device__ __forceinline__ bf16x8 cat8(s16x4 a, s16x4 b) { return __builtin_shufflevector(a, b, 0, 1, 2, 3, 4, 5, 6, 7); }

#define XB_TMO      128
#define XB_XCNT(j)  (256  + 64 * (j))
#define XB_XSUB(j)  (1280 + 64 * (j))
#define XB_XGEN(j)  (2304 + 64 * (j))
#define XB_TOP      3328
#define XB_TOPGEN   3392
#define XCD_BAR_WORDS 3456
#define XB_SPIN_CAP (1u << 18)
__device__ __forceinline__ unsigned xb_ld(unsigned* p)              { return __hip_atomic_load(p, __ATOMIC_RELAXED, __HIP_MEMORY_SCOPE_AGENT); }
__device__ __forceinline__ unsigned xb_add(unsigned* p, unsigned v) { return __hip_atomic_fetch_add(p, v, __ATOMIC_RELAXED, __HIP_MEMORY_SCOPE_AGENT); }
__device__ __forceinline__ unsigned xb_xcc_id() { return (unsigned)__builtin_amdgcn_s_getreg((3 << 11) | 20) & 0xFu; }
#define XB_SPIN(cond, bar) do { unsigned _sp = 0; while (cond) { __builtin_amdgcn_s_sleep(1); \
    if ((++_sp & 255u) == 0u) { if (xb_ld(&(bar)[XB_TMO])) break; if (_sp > XB_SPIN_CAP) { atomicAdd(&(bar)[XB_TMO], 1u); break; } } } } while (0)
struct XcdBarrier { unsigned* bar; unsigned x; volatile LAS unsigned* st; };
__device__ __forceinline__ XcdBarrier xcd_barrier_post(unsigned* bar, volatile LAS unsigned* st) {
    XcdBarrier b; b.bar = bar; b.x = xb_xcc_id(); b.st = st;
    if (threadIdx.x == 0) (void)xb_add(&bar[XB_XCNT(b.x)], 1u);
    return b;
}
__device__ __forceinline__ void xcd_barrier_complete(unsigned* bar, unsigned x, unsigned& nloc, unsigned& nx) {
    const unsigned G = gridDim.x * gridDim.y * gridDim.z;
    unsigned sum, cnt, mine, sp = 0u;
    for (;;) {
        sum = 0u; cnt = 0u; mine = 0u;
#pragma unroll
        for (unsigned j = 0; j < 16; ++j) { const unsigned c = xb_ld(&bar[XB_XCNT(j)]); sum += c; cnt += (c > 0u) ? 1u : 0u; mine = (j == x) ? c : mine; }
        if (sum == G) break;
        __builtin_amdgcn_s_sleep(1);
        if ((++sp & 255u) == 0u) { if (xb_ld(&bar[XB_TMO])) break; if (sp > XB_SPIN_CAP) { atomicAdd(&bar[XB_TMO], 1u); break; } }
    }
    nloc = mine > 0u ? mine : 1u; nx = cnt > 0u ? cnt : 1u;
}
__device__ __forceinline__ void xcd_barrier(const XcdBarrier& b) {
    asm volatile("s_waitcnt vmcnt(0)" ::: "memory");
    __syncthreads();
    if (threadIdx.x == 0) {
        unsigned* bar = b.bar;
        __builtin_amdgcn_s_waitcnt(0);
        unsigned nloc = b.st[0], nx = b.st[1];
        if (nloc == 0u) { xcd_barrier_complete(bar, b.x, nloc, nx); b.st[0] = nloc; b.st[1] = nx; }
        const unsigned old = xb_add(&bar[XB_XSUB(b.x)], 1u);
        const unsigned gen = old / nloc;
        if (old + 1u == (gen + 1u) * nloc) {
            __builtin_amdgcn_fence(__ATOMIC_RELEASE, "agent");
            asm volatile("s_waitcnt vmcnt(0)" ::: "memory");
            const unsigned og = xb_add(&bar[XB_TOP], 1u);
            const unsigned tg = og / nx;
            if (og + 1u == (tg + 1u) * nx) xb_add(&bar[XB_TOPGEN], 1u);
            else XB_SPIN(xb_ld(&bar[XB_TOPGEN]) == tg, bar);
            __builtin_amdgcn_fence(__ATOMIC_ACQUIRE, "agent");
            xb_add(&bar[XB_XGEN(b.x)], 1u);
            asm volatile("s_waitcnt vmcnt(0)" ::: "memory");
        } else {
            XB_SPIN(xb_ld(&bar[XB_XGEN(b.x)]) == gen, bar);
            __builtin_amdgcn_fence(__ATOMIC_ACQUIRE, "agent");
            asm volatile("s_waitcnt vmcnt(0)" ::: "memory");
        }
    }
    __syncthreads();
}

namespace pg8 {
constexpr int BM = 256, BK = 64, HALF = 128, HTB = HALF * BK * 2, STAGE_BYTES = 8 * HTB, NXCD = 8, WGM = 8;
__device__ __forceinline__ int lds_byte(int r, int c) { const int st = (r >> 4) * 2 + (c >> 5), rr = r & 15, cc = c & 31, ob = rr * 64 + cc * 2; return st * 1024 + (ob ^ (((ob >> 9) & 1) << 5)); }
__device__ __forceinline__ void stage_rc(int b, int& R, int& C) { const int st = b / 1024, sb = b % 1024, swz = sb ^ (((sb >> 9) & 1) << 5); R = (st >> 1) * 16 + swz / 64; C = (st & 1) * 32 + (swz % 64) / 2; }
__device__ __forceinline__ int perm32(int rho) { const int n = rho >> 4, i = rho & 15; return 8 * (i >> 2) + 4 * n + (i & 3); }
struct Unit { int pm, pn, e; };

template <int WGM_ = WGM>
__device__ __forceinline__ bool unit_of(long L, int nM, int nN, Unit& u) {
    constexpr int WGM = WGM_;
    const int nwg = nM * nN; if (L >= nwg) return false;
    int wgid = (int)L; { const int q = nwg / NXCD, r = nwg % NXCD, xcd = wgid % NXCD, off = wgid / NXCD; wgid = (xcd < r ? xcd * (q + 1) : r * (q + 1) + (xcd - r) * q) + off; }
    const int nig = WGM * nN, gid = wgid / nig, fm = gid * WGM, gsz = (nM - fm) < WGM ? (nM - fm) : WGM;
    u.pm = fm + ((wgid % nig) % gsz); u.pn = (wgid % nig) / gsz; u.e = 0; return true;
}
struct SchedDense {
    int nM, nN, G, c, K; const char* Bt;
    __device__ __forceinline__ bool next(int i, Unit& u) const { return unit_of((long)i * G + c, nM, nN, u); }
    __device__ __forceinline__ const char* bbase(const Unit& u) const { return Bt + (size_t)u.pn * 256 * K * 2; }
    __device__ __forceinline__ int rot(const Unit& u) const { return u.pm + 2 * u.pn; }
    __device__ __forceinline__ void aoff(const Unit& u, const int (&R)[2], const int (&C)[2], unsigned (&v)[2][2]) const {
#pragma unroll
        for (int h = 0; h < 2; ++h)
#pragma unroll
            for (int i = 0; i < 2; ++i) v[h][i] = (unsigned)((u.pm * 256 + h * 128 + R[i]) * K + C[i]) * 2u;
    }
};
struct SchedMoE {
    int nM, nN, G, c, K; const char* Bt; size_t estride; const int* tile_expert; const int* rowidx;
#ifndef MK_MOE_WGM
#define MK_MOE_WGM 4
#endif
    __device__ __forceinline__ bool next(int i, Unit& u) const { if (!unit_of<MK_MOE_WGM>((long)i * G + c, nM, nN, u)) return false; u.e = __builtin_amdgcn_readfirstlane(tile_expert[u.pm]); return true; }
    __device__ __forceinline__ const char* bbase(const Unit& u) const { return Bt + (size_t)u.e * estride + (size_t)u.pn * 256 * K * 2; }
#ifndef MK_MOE_ROT
#define MK_MOE_ROT 2
#endif
    __device__ __forceinline__ int rot(const Unit& u) const { return MK_MOE_ROT == 1 ? u.pm + 2 * u.pn : (MK_MOE_ROT == 2 ? u.pm + u.pn : 0); }
    __device__ __forceinline__ void aoff(const Unit& u, const int (&R)[2], const int (&C)[2], unsigned (&v)[2][2]) const {
#pragma unroll
        for (int h = 0; h < 2; ++h)
#pragma unroll
            for (int i = 0; i < 2; ++i) { const int r = u.pm * 256 + h * 128 + R[i]; const int src = rowidx ? rowidx[r] : r; v[h][i] = (unsigned)(src * K + C[i]) * 2u; }
    }
};

template <bool I8> struct AccSel { typedef f32x4 T; };
template <> struct AccSel<true> { typedef i32x4 T; };
template <class Epi, class Sched, bool I8 = false>
__device__ __forceinline__ void gemm_phase(LAS unsigned char* lds, const char* gA, const Sched& S, const Epi& E) {
    typedef typename AccSel<I8>::T acc_t;
    const int tid = threadIdx.x, wid = __builtin_amdgcn_readfirstlane(tid >> 6), lane = tid & 63, wr = wid >> 2, wc = wid & 3, fr = lane & 15, fq = lane >> 4;
    const int K = S.K, nt = K / BK;
    int Rr[2], Cc[2]; unsigned voffB[2];
#pragma unroll
    for (int i = 0; i < 2; ++i) { int R, C; stage_rc(tid * 16 + i * 8192, R, C); Rr[i] = R; Cc[i] = C; const int Rb = (R & ~31) + perm32(R & 31); voffB[i] = (unsigned)(Rb * K + C) * 2u; }
    const size_t kstep = (size_t)(BK * 2);
    const size_t hstep = (size_t)HALF * K * 2;
    const unsigned ldsw = (unsigned)wid * 1024u;
    const int aoff = lds_byte(wr * 64 + fr, fq * 8), boff = lds_byte(wc * 32 + fr, fq * 8);
#define PG8_SA(b, h) (((b) * 2 + (h)) * HTB)
#define PG8_SB(b, h) ((4 + (b) * 2 + (h)) * HTB)
#define PG8_STAGE_B(bufoff, gbase) do { _Pragma("unroll") for (int _i = 0; _i < 2; ++_i) \
        __builtin_amdgcn_global_load_lds((const unsigned*)((const char*)(gbase) + voffB[_i]), (LAS unsigned*)(lds + (bufoff) + ldsw + _i * 8192), 16, 0, 0); } while (0)
#define PG8_STAGE_A(bufoff, gbase, vv) do { _Pragma("unroll") for (int _i = 0; _i < 2; ++_i) \
        __builtin_amdgcn_global_load_lds((const unsigned*)((const char*)(gbase) + (vv)[_i]), (LAS unsigned*)(lds + (bufoff) + ldsw + _i * 8192), 16, 0, 0); } while (0)
#define PG8_LDA(dst, b, h) do { _Pragma("unroll") for (int m = 0; m < 4; ++m) _Pragma("unroll") for (int k = 0; k < 2; ++k) dst[m][k] = *(const LAS bf16x8*)(lds + PG8_SA(b, h) + aoff + m * 2048 + k * 1024); } while (0)
#define PG8_LDB(dst, b, h) do { _Pragma("unroll") for (int n = 0; n < 2; ++n) _Pragma("unroll") for (int k = 0; k < 2; ++k) dst[n][k] = *(const LAS bf16x8*)(lds + PG8_SB(b, h) + boff + n * 2048 + k * 1024); } while (0)
#define PG8_MMA(ai, bj, At, Bt) do { __builtin_amdgcn_s_setprio(1); _Pragma("unroll") for (int m = 0; m < 4; ++m) _Pragma("unroll") for (int n = 0; n < 2; ++n) _Pragma("unroll") for (int k = 0; k < 2; ++k) { \
        if constexpr (I8) acc[ai][bj][m][n] = __builtin_amdgcn_mfma_i32_16x16x64_i8(__builtin_bit_cast(i32x4, Bt[n][k]), __builtin_bit_cast(i32x4, At[m][k]), acc[ai][bj][m][n], 0, 0, 0); \
        else acc[ai][bj][m][n] = __builtin_amdgcn_mfma_f32_16x16x32_bf16(Bt[n][k], At[m][k], acc[ai][bj][m][n], 0, 0, 0); } __builtin_amdgcn_s_setprio(0); } while (0)
#define PG8_WAIT_V(n) asm volatile("s_waitcnt vmcnt(" #n ")" ::: "memory")
#define PG8_WAIT_L(n) asm volatile("s_waitcnt lgkmcnt(" #n ")" ::: "memory")
#define PG8_BAR __builtin_amdgcn_s_barrier()
#define PG8_SCHED __builtin_amdgcn_sched_barrier(0)
    Unit cur, nxt; int ui = 0;
    if (!S.next(0, cur)) return;
    const int ntm = nt - 1;
    int rc = S.rot(cur) & ntm, rn = rc;
    acc_t acc[2][2][4][2];
#pragma unroll
    for (int a = 0; a < 2; ++a)
#pragma unroll
        for (int b = 0; b < 2; ++b)
#pragma unroll
            for (int m = 0; m < 4; ++m)
#pragma unroll
                for (int n = 0; n < 2; ++n) acc[a][b][m][n] = (acc_t){0, 0, 0, 0};
    bf16x8 At[4][2], B0[2][2], B1[2][2];
    unsigned vc[2][2], vn[2][2];
    S.aoff(cur, Rr, Cc, vc);
    const char* cB = S.bbase(cur);
    { const size_t k0 = (size_t)rc * kstep, k1 = (size_t)((rc + 1) & ntm) * kstep;
    PG8_STAGE_B(PG8_SB(0, 0), cB + k0); PG8_STAGE_B(PG8_SB(0, 1), cB + hstep + k0); PG8_STAGE_A(PG8_SA(0, 0), gA + k0, vc[0]); PG8_STAGE_A(PG8_SA(0, 1), gA + k0, vc[1]);
    PG8_STAGE_B(PG8_SB(1, 0), cB + k1); PG8_STAGE_B(PG8_SB(1, 1), cB + hstep + k1); PG8_STAGE_A(PG8_SA(1, 0), gA + k1, vc[0]); }
    if (wr == 1) PG8_BAR;
    PG8_WAIT_V(8); PG8_BAR; PG8_BAR;
    for (;;) {
        const bool has_next = S.next(ui + 1, nxt);
        const char* nB = cB;
        if (has_next) { S.aoff(nxt, Rr, Cc, vn); nB = S.bbase(nxt); rn = S.rot(nxt) & ntm; }
        else { rn = rc;
#pragma unroll
            for (int h = 0; h < 2; ++h)
#pragma unroll
                for (int i = 0; i < 2; ++i) vn[h][i] = vc[h][i];
        }
        for (int t = 0; t < nt; t += 2) {
            const bool last = (t == nt - 2);
            const size_t ko1 = (size_t)((rc + t + 1) & ntm) * kstep;
            const size_t ko2 = (size_t)(last ? rn : ((rc + t + 2) & ntm)) * kstep, ko3 = (size_t)(last ? ((rn + 1) & ntm) : ((rc + t + 3) & ntm)) * kstep;
            const char* a1 = gA + ko1;
            const char* a2 = gA + ko2;
            const char* a3 = gA + ko3;
            unsigned v2[2][2];
#pragma unroll
            for (int h = 0; h < 2; ++h)
#pragma unroll
                for (int i = 0; i < 2; ++i) v2[h][i] = last ? vn[h][i] : vc[h][i];
            const char* bb = last ? nB : cB;
            PG8_LDB(B0, 0, 0); PG8_LDB(B1, 0, 1); PG8_LDA(At, 0, 0); PG8_STAGE_A(PG8_SA(1, 1), a1, vc[1]);
            PG8_WAIT_V(8); PG8_WAIT_L(0); PG8_BAR; PG8_SCHED; PG8_MMA(0, 0, At, B0); PG8_MMA(0, 1, At, B1); PG8_BAR; PG8_SCHED;
            PG8_LDA(At, 0, 1); PG8_STAGE_B(PG8_SB(0, 0), bb + ko2); PG8_STAGE_B(PG8_SB(0, 1), bb + ko2 + hstep); PG8_STAGE_A(PG8_SA(0, 0), a2, v2[0]);
            PG8_WAIT_V(8); PG8_WAIT_L(0); PG8_BAR; PG8_SCHED; PG8_MMA(1, 0, At, B0); PG8_MMA(1, 1, At, B1); PG8_BAR; PG8_SCHED;
            PG8_LDB(B0, 1, 0); PG8_LDB(B1, 1, 1); PG8_LDA(At, 1, 0); PG8_STAGE_A(PG8_SA(0, 1), a2, v2[1]);
            PG8_WAIT_V(8); PG8_WAIT_L(0); PG8_BAR; PG8_SCHED; PG8_MMA(0, 0, At, B0); PG8_MMA(0, 1, At, B1); PG8_BAR; PG8_SCHED;
            PG8_LDA(At, 1, 1); PG8_STAGE_B(PG8_SB(1, 0), bb + ko3); PG8_STAGE_B(PG8_SB(1, 1), bb + ko3 + hstep); PG8_STAGE_A(PG8_SA(1, 0), a3, v2[0]);
            PG8_WAIT_V(8); PG8_WAIT_L(0); PG8_BAR; PG8_SCHED; PG8_MMA(1, 0, At, B0); PG8_MMA(1, 1, At, B1); PG8_BAR; PG8_SCHED;
        }
        E(acc, cur, wr, wc, fr, fq);
        if (!has_next) break;
#pragma unroll
        for (int a = 0; a < 2; ++a)
#pragma unroll
            for (int b = 0; b < 2; ++b)
#pragma unroll
                for (int m = 0; m < 4; ++m)
#pragma unroll
                    for (int n = 0; n < 2; ++n) { unsigned long long z0, z1; asm volatile("v_mov_b64 %0, 0" : "=v"(z0)); asm volatile("v_mov_b64 %0, 0" : "=v"(z1));
                        typedef unsigned long long u64x2_t __attribute__((ext_vector_type(2))); acc[a][b][m][n] = __builtin_bit_cast(acc_t, (u64x2_t){z0, z1}); }
        cur = nxt; cB = nB; rc = rn; ++ui;
#pragma unroll
        for (int h = 0; h < 2; ++h)
#pragma unroll
            for (int i = 0; i < 2; ++i) vc[h][i] = vn[h][i];
    }
    PG8_WAIT_V(0);
    if (wr == 0) PG8_BAR;
    PG8_BAR;
#undef PG8_SA
#undef PG8_SB
#undef PG8_STAGE_A
#undef PG8_STAGE_B
#undef PG8_LDA
#undef PG8_LDB
#undef PG8_MMA
#undef PG8_WAIT_V
#undef PG8_WAIT_L
#undef PG8_BAR
#undef PG8_SCHED
}

#define EPI_LOOP_BEGIN \
    _Pragma("unroll") for (int ai = 0; ai < 2; ++ai) _Pragma("unroll") for (int m = 0; m < 4; ++m) { const int row = u.pm * BM + ai * HALF + wr * 64 + m * 16 + fr; \
    _Pragma("unroll") for (int bj = 0; bj < 2; ++bj) { const int col = u.pn * BM + bj * HALF + wc * 32 + 8 * fq; f32x4 v0 = acc[ai][bj][m][0], v1 = acc[ai][bj][m][1];
#define EPI_LOOP_END } }
__device__ __forceinline__ u32x4 pack8(f32x4 v0, f32x4 v1) { u32x4 w; w.x = pk2(v0[0], v0[1]); w.y = pk2(v0[2], v0[3]); w.z = pk2(v1[0], v1[1]); w.w = pk2(v1[2], v1[3]); return w; }

template <int MODE> struct EpiProj {
    bf16_t* O; int ldc; const float* rope; const float* rs0; const float* sw; int permute;
    __device__ __forceinline__ void operator()(const i32x4 (&acc)[2][2][4][2], const Unit& u, int wr, int wc, int fr, int fq) const {
        const int row0 = u.pm * BM + wr * 64 + fr, colb = u.pn * BM + wc * 32 + 8 * fq;
        float rsr[8]; f32x4 s0[2], s1[2];
#pragma unroll
        for (int i = 0; i < 8; ++i) rsr[i] = rs0[row0 + (i >> 2) * HALF + (i & 3) * 16];
#pragma unroll
        for (int bj = 0; bj < 2; ++bj) { s0[bj] = *(const f32x4*)(sw + colb + bj * HALF); s1[bj] = *(const f32x4*)(sw + colb + bj * HALF + 4); }
#pragma unroll
        for (int ai = 0; ai < 2; ++ai) {
            f32x4 csv[4][2], snv[4][2];
            if (MODE == 2 && u.pn < 4) {
#pragma unroll
                for (int m = 0; m < 4; ++m)
#pragma unroll
                    for (int bj = 0; bj < 2; ++bj) { const int s = (row0 + ai * HALF + m * 16) & (SEQ - 1), i0 = ((colb + bj * HALF) & 127) >> 1; csv[m][bj] = *(const f32x4*)(rope + s * 64 + i0); snv[m][bj] = *(const f32x4*)(rope + SEQ * 64 + s * 64 + i0); }
            }
#pragma unroll
        for (int m = 0; m < 4; ++m) { const int row = row0 + ai * HALF + m * 16; const float rsv = rsr[ai * 4 + m];
#pragma unroll
        for (int bj = 0; bj < 2; ++bj) { const int col = colb + bj * HALF;
            f32x4 v0, v1;
#pragma unroll
            for (int j = 0; j < 4; ++j) { v0[j] = (float)acc[ai][bj][m][0][j] * (s0[bj][j] * rsv); v1[j] = (float)acc[ai][bj][m][1][j] * (s1[bj][j] * rsv); }
            if (MODE == 2) {
                if (u.pn < 4) {
                    const int head = 2 * (u.pn & 1) + bj;
                    const float lg = __builtin_log2f(1.0f - __builtin_amdgcn_exp2f(-5.0f - (float)head));
                    const float ii = (float)(row & 127);
                    const float fac = __builtin_amdgcn_exp2f((u.pn < 2 ? ii : -ii) * lg);
                    const f32x4 c4 = csv[m][bj], s4 = snv[m][bj];
                    f32x4 r0, r1;
                    r0[0] = (v0[0] * c4[0] - v0[1] * s4[0]) * fac; r0[1] = (v0[0] * s4[0] + v0[1] * c4[0]) * fac;
                    r0[2] = (v0[2] * c4[1] - v0[3] * s4[1]) * fac; r0[3] = (v0[2] * s4[1] + v0[3] * c4[1]) * fac;
                    r1[0] = (v1[0] * c4[2] - v1[1] * s4[2]) * fac; r1[1] = (v1[0] * s4[2] + v1[1] * c4[2]) * fac;
                    r1[2] = (v1[2] * c4[3] - v1[3] * s4[3]) * fac; r1[3] = (v1[2] * s4[3] + v1[3] * c4[3]) * fac;
                    v0 = r0; v1 = r1;
                } else if (u.pn >= 8) {
#pragma unroll
                    for (int j = 0; j < 4; ++j) { v0[j] = v0[j] * sigmoidf_(v0[j]); v1[j] = v1[j] * sigmoidf_(v1[j]); }
                }
            }
            if (MODE == 3) {
                u32x2 d;
                { const unsigned f0 = __float_as_uint(fmaf(sigmoidf_(v0[0]), 255.0f, 12582912.0f)), f1 = __float_as_uint(fmaf(sigmoidf_(v0[1]), 255.0f, 12582912.0f)), f2 = __float_as_uint(fmaf(sigmoidf_(v0[2]), 255.0f, 12582912.0f)), f3 = __float_as_uint(fmaf(sigmoidf_(v0[3]), 255.0f, 12582912.0f));
                  d.x = pack_lo4(f0, f1, f2, f3); }
                { const unsigned f0 = __float_as_uint(fmaf(sigmoidf_(v1[0]), 255.0f, 12582912.0f)), f1 = __float_as_uint(fmaf(sigmoidf_(v1[1]), 255.0f, 12582912.0f)), f2 = __float_as_uint(fmaf(sigmoidf_(v1[2]), 255.0f, 12582912.0f)), f3 = __float_as_uint(fmaf(sigmoidf_(v1[3]), 255.0f, 12582912.0f));
                  d.y = pack_lo4(f0, f1, f2, f3); }
                *(u32x2*)((unsigned char*)O + (size_t)row * ldc + col) = d;
                continue;
            }
            int orow = row;
            if (MODE == 0 && permute) { const int lgp = 2 * ((u.pn % 6) >> 1), sq = row & (SEQ - 1); orow = (row & ~(SEQ - 1)) | ((sq & ((1 << lgp) - 1)) << (12 - lgp)) | (sq >> lgp); }
            *(u32x4*)(O + (size_t)orow * ldc + col) = pack8(v0, v1);
        } } }
    }
};
#define GATE8(w, k) ((float)(((w) >> (8 * (k))) & 255u) * (1.0f / 255.0f))
struct EpiM1 {
    bf16_t* O; const unsigned char* gate;
    __device__ __forceinline__ void operator()(const f32x4 (&acc)[2][2][4][2], const Unit& u, int wr, int wc, int fr, int fq) const {
        const int row0 = u.pm * BM + wr * 64 + fr, colb = u.pn * BM + wc * 32 + 8 * fq;
        u32x2 gwa[2][4][2];
#pragma unroll
        for (int ai = 0; ai < 2; ++ai)
#pragma unroll
            for (int m = 0; m < 4; ++m)
#pragma unroll
                for (int bj = 0; bj < 2; ++bj) gwa[ai][m][bj] = *(const u32x2*)(gate + (size_t)(row0 + ai * HALF + m * 16) * N_GATE + colb + bj * HALF);
#pragma unroll
        for (int ai = 0; ai < 2; ++ai) {
#pragma unroll
            for (int m = 0; m < 4; ++m)
#pragma unroll
                for (int bj = 0; bj < 2; ++bj) { const u32x2 g = gwa[ai][m][bj]; f32x4 v0 = acc[ai][bj][m][0], v1 = acc[ai][bj][m][1];
                    v0[0] *= GATE8(g.x, 0); v0[1] *= GATE8(g.x, 1); v0[2] *= GATE8(g.x, 2); v0[3] *= GATE8(g.x, 3);
                    v1[0] *= GATE8(g.y, 0); v1[1] *= GATE8(g.y, 1); v1[2] *= GATE8(g.y, 2); v1[3] *= GATE8(g.y, 3);
                    *(u32x4*)(O + (size_t)(row0 + ai * HALF + m * 16) * DM + colb + bj * HALF) = pack8(v0, v1); }
        }
    }
};
struct EpiMerge {
    bf16_t* O; const unsigned char* gate; const bf16_t* M1;
    __device__ __forceinline__ void operator()(const f32x4 (&acc)[2][2][4][2], const Unit& u, int wr, int wc, int fr, int fq) const {
        const int row0 = u.pm * BM + wr * 64 + fr, colb = u.pn * BM + wc * 32 + 8 * fq;
#pragma unroll
        for (int ai = 0; ai < 2; ++ai) {
            u32x2 gw[4][2]; u32x4 mw[4][2];
#pragma unroll
            for (int m = 0; m < 4; ++m)
#pragma unroll
                for (int bj = 0; bj < 2; ++bj) { const size_t r = (size_t)(row0 + ai * HALF + m * 16); gw[m][bj] = *(const u32x2*)(gate + r * N_GATE + 1024 + colb + bj * HALF); mw[m][bj] = *(const u32x4*)(M1 + r * DM + colb + bj * HALF); }
#pragma unroll
            for (int m = 0; m < 4; ++m)
#pragma unroll
                for (int bj = 0; bj < 2; ++bj) { const u32x2 g = gw[m][bj]; const u32x4 q = mw[m][bj]; f32x4 v0 = acc[ai][bj][m][0], v1 = acc[ai][bj][m][1];
                    v0[0] = v0[0] * GATE8(g.x, 0) + bflo(q.x); v0[1] = v0[1] * GATE8(g.x, 1) + bfhi(q.x); v0[2] = v0[2] * GATE8(g.x, 2) + bflo(q.y); v0[3] = v0[3] * GATE8(g.x, 3) + bfhi(q.y);
                    v1[0] = v1[0] * GATE8(g.y, 0) + bflo(q.z); v1[1] = v1[1] * GATE8(g.y, 1) + bfhi(q.z); v1[2] = v1[2] * GATE8(g.y, 2) + bflo(q.w); v1[3] = v1[3] * GATE8(g.y, 3) + bfhi(q.w);
                    *(u32x4*)(O + (size_t)(row0 + ai * HALF + m * 16) * DM + colb + bj * HALF) = pack8(v0, v1); }
        }
    }
};
#undef GATE8
struct EpiX1 {
    const float* x; float* x1; float* stats;
    __device__ __forceinline__ void operator()(const f32x4 (&acc)[2][2][4][2], const Unit& u, int wr, int wc, int fr, int fq) const {
        const int row0 = u.pm * BM + wr * 64 + fr, colb = u.pn * BM + wc * 32 + 8 * fq;
#pragma unroll
        for (int ai = 0; ai < 2; ++ai) {
            f32x4 xv[4][2][2];
#pragma unroll
            for (int m2 = 0; m2 < 4; ++m2)
#pragma unroll
                for (int bj = 0; bj < 2; ++bj) { const size_t o = (size_t)(row0 + ai * HALF + m2 * 16) * DM + colb + bj * HALF; xv[m2][bj][0] = *(const f32x4*)(x + o); xv[m2][bj][1] = *(const f32x4*)(x + o + 4); }
#pragma unroll
            for (int m2 = 0; m2 < 4; ++m2) { const int m = m2, row = row0 + ai * HALF + m * 16; float ss = 0.f, am = 0.f;
#pragma unroll
                for (int bj = 0; bj < 2; ++bj) { const size_t o = (size_t)row * DM + colb + bj * HALF;
                    const f32x4 v0 = acc[ai][bj][m][0] + xv[m2][bj][0], v1 = acc[ai][bj][m][1] + xv[m2][bj][1];
                    *(f32x4*)(x1 + o) = v0; *(f32x4*)(x1 + o + 4) = v1;
#pragma unroll
                    for (int j = 0; j < 4; ++j) { ss += v0[j] * v0[j]; ss += v1[j] * v1[j]; am = fmaxf(am, fmaxf(fabsf(v0[j]), fabsf(v1[j]))); } }
                ss = xr_sum(ss); am = xr_max(am);
                if (fq == 0) { f32x2 st; st.x = ss; st.y = am; *(f32x2*)(stats + ((size_t)row * 16 + u.pn * 4 + wc) * 2) = st; } }
        }
    }
};
struct EpiSwiglu {
    bf16_t* act; const float* b1; const float* rs; const float* sw;
    __device__ __forceinline__ void operator()(const i32x4 (&acc)[2][2][4][2], const Unit& u, int wr, int wc, int fr, int fq) const {
        const int c0 = u.pn * 128 + wc * 32 + 8 * fq;
        const float* bg = b1 + (size_t)u.e * 2048 + c0; const float* bu = bg + 1024;
        const f32x4 bg0 = *(const f32x4*)bg, bg1 = *(const f32x4*)(bg + 4), bu0 = *(const f32x4*)bu, bu1 = *(const f32x4*)(bu + 4);
        const float* sg = sw + (size_t)u.e * 2048 + u.pn * 256 + wc * 32 + 8 * fq; const float* su = sg + 128;
        const f32x4 sg0 = *(const f32x4*)sg, sg1 = *(const f32x4*)(sg + 4), su0 = *(const f32x4*)su, su1 = *(const f32x4*)(su + 4);
        float rsr[8];
#pragma unroll
        for (int i = 0; i < 8; ++i) rsr[i] = rs[u.pm * BM + (i >> 2) * HALF + wr * 64 + (i & 3) * 16 + fr];
#pragma unroll
        for (int ai = 0; ai < 2; ++ai)
#pragma unroll
            for (int m = 0; m < 4; ++m) {
                const int row = u.pm * BM + ai * HALF + wr * 64 + m * 16 + fr;
                const float r = rsr[ai * 4 + m];
                const float qs = 1.0f / ACT_STEP, kx = -1.702f * LOG2E;
                unsigned q[8];
#pragma unroll
                for (int j = 0; j < 4; ++j) {
                    float g = fminf((float)acc[ai][0][m][0][j] * (r * sg0[j]) + bg0[j], 7.0f), up = fminf(fmaxf((float)acc[ai][1][m][0][j] * (r * su0[j]) + bu0[j], -7.0f), 7.0f);
                    float t = g * fast_rcp(1.0f + fast_exp2(g * kx)); float a = fmaf(up, t, t);
                    q[j] = __float_as_uint(fmaf(fminf(fmaxf(a, -12.0f), 12.0f), qs, 12582912.0f));
                    g = fminf((float)acc[ai][0][m][1][j] * (r * sg1[j]) + bg1[j], 7.0f); up = fminf(fmaxf((float)acc[ai][1][m][1][j] * (r * su1[j]) + bu1[j], -7.0f), 7.0f);
                    t = g * fast_rcp(1.0f + fast_exp2(g * kx)); a = fmaf(up, t, t);
                    q[4 + j] = __float_as_uint(fmaf(fminf(fmaxf(a, -12.0f), 12.0f), qs, 12582912.0f));
                }
                u32x2 ow; ow.x = pack_lo4(q[0], q[1], q[2], q[3]); ow.y = pack_lo4(q[4], q[5], q[6], q[7]);
                *(u32x2*)((signed char*)act + (size_t)row * DEXP + c0) = ow;
            }
    }
};
struct EpiDown {
    unsigned char* Y; float* YS; const float* b2; const float* w; const float* sw;
    __device__ __forceinline__ void operator()(const i32x4 (&acc)[2][2][4][2], const Unit& u, int wr, int wc, int fr, int fq) const {
        const int row0 = u.pm * BM + wr * 64 + fr, colb = u.pn * BM + wc * 32 + 8 * fq;
        float wt[8]; f32x4 s0[2], s1[2], b0[2], b1v[2];
#pragma unroll
        for (int i = 0; i < 8; ++i) wt[i] = w[row0 + (i >> 2) * HALF + (i & 3) * 16];
#pragma unroll
        for (int bj = 0; bj < 2; ++bj) { const float* bb = b2 + (size_t)u.e * DM + colb + bj * HALF; const float* sp = sw + (size_t)u.e * DM + colb + bj * HALF;
            s0[bj] = *(const f32x4*)sp * ACT_STEP; s1[bj] = *(const f32x4*)(sp + 4) * ACT_STEP; b0[bj] = *(const f32x4*)bb; b1v[bj] = *(const f32x4*)(bb + 4); }
#pragma unroll
        for (int ai = 0; ai < 2; ++ai)
#pragma unroll
        for (int m = 0; m < 4; ++m) { const int row = row0 + ai * HALF + m * 16; const float wv = wt[ai * 4 + m];
            f32x4 y[2][2]; float am = 0.f;
#pragma unroll
            for (int bj = 0; bj < 2; ++bj)
#pragma unroll
                for (int j = 0; j < 4; ++j) { y[bj][0][j] = (float)acc[ai][bj][m][0][j] * s0[bj][j] + b0[bj][j]; y[bj][1][j] = (float)acc[ai][bj][m][1][j] * s1[bj][j] + b1v[bj][j];
                    am = fmaxf(fmaxf(am, fabsf(y[bj][0][j])), fabsf(y[bj][1][j])); }
            am = xr_max(am);
            const float inv = am > 0.f ? 127.0f / am : 0.f;
#pragma unroll
            for (int bj = 0; bj < 2; ++bj) { u32x2 d;
                { const unsigned f0 = __float_as_uint(fmaf(y[bj][0][0], inv, 12583040.0f)), f1 = __float_as_uint(fmaf(y[bj][0][1], inv, 12583040.0f)), f2 = __float_as_uint(fmaf(y[bj][0][2], inv, 12583040.0f)), f3 = __float_as_uint(fmaf(y[bj][0][3], inv, 12583040.0f));
                  d.x = pack_lo4(f0, f1, f2, f3); }
                { const unsigned f0 = __float_as_uint(fmaf(y[bj][1][0], inv, 12583040.0f)), f1 = __float_as_uint(fmaf(y[bj][1][1], inv, 12583040.0f)), f2 = __float_as_uint(fmaf(y[bj][1][2], inv, 12583040.0f)), f3 = __float_as_uint(fmaf(y[bj][1][3], inv, 12583040.0f));
                  d.y = pack_lo4(f0, f1, f2, f3); }
                *(u32x2*)(Y + (size_t)row * DM + colb + bj * HALF) = d; }
            if (fq == 0) YS[(size_t)row * 16 + u.pn * 4 + wc] = am * (1.0f / 127.0f) * wv;
        }
    }
};
}

__device__ const unsigned char T5B[3][129] = {
{0,1,2,3,4,5,6,7,8,9,10,11,12,13,14,15,16,16,16,16,16,16,17,17,17,17,17,17,17,17,18,18,18,18,18,18,18,18,18,18,19,19,19,19,19,19,19,19,19,19,19,19,19,19,20,20,20,20,20,20,20,20,20,20,20,20,20,20,20,20,20,20,20,21,21,21,21,21,21,21,21,21,21,21,21,21,21,21,21,21,21,21,21,21,21,21,21,21,21,22,22,22,22,22,22,22,22,22,22,22,22,22,22,22,22,22,22,22,22,22,22,22,22,22,22,22,22,22,22},
{0,4,8,12,16,16,17,17,18,18,19,19,19,19,20,20,20,20,20,21,21,21,21,21,21,22,22,22,22,22,22,22,22,22,23,23,23,23,23,23,23,23,23,23,23,23,24,24,24,24,24,24,24,24,24,24,24,24,24,24,24,24,25,25,25,25,25,25,25,25,25,25,25,25,25,25,25,25,25,25,25,25,25,26,26,26,26,26,26,26,26,26,26,26,26,26,26,26,26,26,26,26,26,26,26,26,26,26,26,26,26,26,26,27,27,27,27,27,27,27,27,27,27,27,27,27,27,27,27},
{0,16,18,19,20,21,21,22,22,23,23,23,24,24,24,24,25,25,25,25,25,26,26,26,26,26,26,26,26,27,27,27,27,27,27,27,27,27,27,28,28,28,28,28,28,28,28,28,28,28,28,28,29,29,29,29,29,29,29,29,29,29,29,29,29,29,29,29,29,29,30,30,30,30,30,30,30,30,30,30,30,30,30,30,30,30,30,30,30,30,30,30,30,30,30,31,31,31,31,31,31,31,31,31,31,31,31,31,31,31,31,31,31,31,31,31,31,31,31,31,31,31,31,31,31,31,31,31,31}};

struct Frame {
    LAS unsigned char* lds;
    int tid, lane, wave, G;
    unsigned char* ws; unsigned char* dout;
    const float* in[15];
};
struct Args { const float* in[15]; float* out; unsigned char* ws; int ph_lo, ph_hi;
 };

template <int CS_MODE  , int NMAP  >
__device__ __forceinline__ void p0_transpose_item(const float* W, int K, int N, int ld, bf16_t* WT, const float* rs, LAS float* scr, int item, int lane) {
    const int nblk = N / 64, kb = item / nblk, nb = item % nblk, k0 = 64 * kb, n0 = 64 * nb;
    const int lr = lane >> 4, lc = (lane & 15) * 4;
    f32x4 v[16];
#pragma unroll
    for (int i = 0; i < 16; ++i) v[i] = *(const f32x4*)(W + (size_t)(k0 + 4 * i + lr) * ld + n0 + lc);
#pragma unroll
    for (int i = 0; i < 16; ++i) {
        const int kk = 4 * i + lr; const float r = rs ? rs[k0 + kk] : 1.0f;
        scr[kk * 65 + lc + 0] = v[i][0] * r; scr[kk * 65 + lc + 1] = v[i][1] * r; scr[kk * 65 + lc + 2] = v[i][2] * r; scr[kk * 65 + lc + 3] = v[i][3] * r;
    }
    LDS_WAIT(); asm volatile("" ::: "memory");
    const int c = lane & 7;
#pragma unroll
    for (int j = 0; j < 8; ++j) {
        const int nl = (lane >> 3) + 8 * j, n = n0 + nl; const LAS float* sp = scr + (8 * c) * 65 + nl;
        float cs = 1.0f;
        if (CS_MODE == 2) { if (n >= 512 && n < 1024) cs = 0.08838834764831845f; }
        int nm = n;
        if (NMAP == 1) { nm = (n < 1024) ? (256 * (n >> 7) + (n & 127)) : (256 * ((n - 1024) >> 7) + 128 + ((n - 1024) & 127)); }
        u32x4 o; o.x = pk2(sp[0 * 65] * cs, sp[1 * 65] * cs); o.y = pk2(sp[2 * 65] * cs, sp[3 * 65] * cs); o.z = pk2(sp[4 * 65] * cs, sp[5 * 65] * cs); o.w = pk2(sp[6 * 65] * cs, sp[7 * 65] * cs);
        *(u32x4*)(WT + (size_t)nm * K + k0 + 8 * c) = o;
    }
    LDS_WAIT(); asm volatile("" ::: "memory");
}
struct QItem { int map, ld, n0, rot; const float* W; const float* rs; signed char* Q; float* SW; };
#define P0_NMAP(MAP, n) ((MAP) == 1 ? (((n) < 1024) ? (256 * ((n) >> 7) + ((n) & 127)) : (256 * (((n) - 1024) >> 7) + 128 + (((n) - 1024) & 127))) : (n))
__device__ __forceinline__ void p0q_load(const Frame& F, const QItem& q, f32x4 (&v)[32], float (&rsv)[32]) {
    const int lr = F.lane >> 4, lc4 = F.lane & 15, w = F.wave;
    const unsigned voff = (unsigned)(((128 * w + 4 * lr) * q.ld + q.n0 + 4 * lc4) * 4);
    const float* rsl = q.rs + 128 * w + 4 * lr;
#pragma unroll
    for (int i = 0; i < 32; ++i) { const int kk = 16 * (((i >> 2) + q.rot) & 7) + (i & 3); v[i] = *(const f32x4*)((const char*)q.W + (size_t)kk * q.ld * 4 + voff); rsv[i] = rsl[kk]; }
}
__device__ __forceinline__ void p0_quant_all(Frame& F, const float* w1, const float* w2, const float* w_in, const float* g_ffn, const float* g_mix) {
    LAS float* cm = (LAS float*)(F.lds + 8 * 16896);
    LAS unsigned* Tl = (LAS unsigned*)(F.lds + F.wave * 16896);
    const int lr = F.lane >> 4, lc4 = F.lane & 15, w = F.wave;
    constexpr int NIT = NEXP * 32 + 152 + NEXP * 16;
    auto item = [&](int it) { QItem q;
        if (it < NEXP * 32) { const int e = it >> 5; q.map = 1; q.rot = e & 7; q.W = w1 + (size_t)e * 1024 * 2048; q.ld = 2048; q.n0 = (it & 31) * 64; q.rs = g_ffn; q.Q = (signed char*)(F.ws + WS_W1) + (size_t)e * 2048 * 1024; q.SW = (float*)(F.ws + WS_SW1) + e * 2048; }
        else if (it < NEXP * 32 + 152) { q.map = 2; q.rot = 0; q.W = w_in; q.ld = PROJ_W; q.n0 = (it - NEXP * 32) * 64; q.rs = g_mix; q.Q = (signed char*)(F.ws + WS_WINQ); q.SW = (float*)(F.ws + WS_SWIN); }
        else { const int r2 = it - NEXP * 32 - 152, e = r2 >> 4; q.map = 0; q.rot = e & 7; q.W = w2 + (size_t)e * 1024 * 1024; q.ld = 1024; q.n0 = (r2 & 15) * 64; q.rs = nullptr; q.Q = (signed char*)(F.ws + WS_W2) + (size_t)e * 1024 * 1024; q.SW = (float*)(F.ws + WS_SW2) + e * 1024; }
        return q; };
    f32x4 v[32]; float rsv[32];
    int it = blockIdx.x;
    QItem q = item(it < NIT ? it : 0);
    if (q.rs == nullptr) q.rs = g_mix;
    if (it < NIT) p0q_load(F, q, v, rsv);
    while (it < NIT) {
        const int itn = it + F.G; const bool has = itn < NIT;
        QItem qn = item(has ? itn : it); if (qn.rs == nullptr) qn.rs = g_mix;
        const int MAP = q.map;
        f32x4 mx = {0.f, 0.f, 0.f, 0.f};
#pragma unroll
        for (int i = 0; i < 32; ++i) { if (MAP != 0) v[i] *= rsv[i]; mx[0] = fmaxf(mx[0], fabsf(v[i][0])); mx[1] = fmaxf(mx[1], fabsf(v[i][1])); mx[2] = fmaxf(mx[2], fabsf(v[i][2])); mx[3] = fmaxf(mx[3], fabsf(v[i][3])); }
#pragma unroll
        for (int c = 0; c < 4; ++c) { mx[c] = fmaxf(mx[c], __shfl_xor(mx[c], 16)); mx[c] = fmaxf(mx[c], __shfl_xor(mx[c], 32)); }
        __syncthreads();
        if (lr == 0) *(LAS f32x4*)(cm + w * 64 + 4 * lc4) = mx;
        __syncthreads();
#pragma unroll
        for (int ww = 0; ww < 8; ++ww) { const f32x4 o = *(const LAS f32x4*)(cm + ww * 64 + 4 * lc4); mx[0] = fmaxf(mx[0], o[0]); mx[1] = fmaxf(mx[1], o[1]); mx[2] = fmaxf(mx[2], o[2]); mx[3] = fmaxf(mx[3], o[3]); }
        f32x4 inv;
#pragma unroll
        for (int c = 0; c < 4; ++c) inv[c] = mx[c] > 0.f ? 127.0f / mx[c] : 0.f;
        if (w == 0 && lr == 0) {
#pragma unroll
            for (int c = 0; c < 4; ++c) { const int n = q.n0 + 4 * lc4 + c; float st = mx[c] * (1.0f / 127.0f); if (MAP == 2 && n < 1536) st *= 0.08838834764831845f * LOG2E; if (MAP == 2 && n >= 5120 && n < 5632) st *= 0.08838834764831845f; q.SW[P0_NMAP(MAP, n)] = st; }
        }
#pragma unroll
        for (int j = 0; j < 8; ++j)
#pragma unroll
            for (int c = 0; c < 4; ++c) {
                const unsigned q0 = __float_as_uint(fmaf(v[4 * j + 0][c], inv[c], 12582912.0f)), q1 = __float_as_uint(fmaf(v[4 * j + 1][c], inv[c], 12582912.0f)), q2 = __float_as_uint(fmaf(v[4 * j + 2][c], inv[c], 12582912.0f)), q3 = __float_as_uint(fmaf(v[4 * j + 3][c], inv[c], 12582912.0f));
                Tl[(4 * lc4 + c) * 33 + 4 * ((j + q.rot) & 7) + lr] = pack_lo4(q0, q1, q2, q3);
            }
        if (has) p0q_load(F, qn, v, rsv);
        LDS_WAIT(); asm volatile("" ::: "memory");
#pragma unroll
        for (int jj = 0; jj < 8; ++jj) {
            const int nl = (F.lane >> 3) + 8 * jj, ch = F.lane & 7, n = q.n0 + nl;
            u32x4 o; o.x = Tl[nl * 33 + 4 * ch + 0]; o.y = Tl[nl * 33 + 4 * ch + 1]; o.z = Tl[nl * 33 + 4 * ch + 2]; o.w = Tl[nl * 33 + 4 * ch + 3];
            *(u32x4*)(q.Q + (size_t)P0_NMAP(MAP, n) * 1024 + 128 * w + 16 * ch) = o;
        }
        LDS_WAIT(); asm volatile("" ::: "memory");
        q = qn; it = itn;
    }
    __syncthreads();
}
#undef P0_NMAP
__device__ __forceinline__ void p0_prologue(Frame& F) {
    LAS float* scr = (LAS float*)(F.lds + F.wave * 16896);
    const int gw = blockIdx.x * 8 + F.wave, NGW = F.G * 8;
    const float* x = F.in[0]; const float* g_mix = F.in[1]; const float* w_in = F.in[2]; const float* rel_bias = F.in[3];
    const float* w_att = F.in[4]; const float* w_ret = F.in[5]; const float* w_out = F.in[6]; const float* g_ffn = F.in[7];
    const float* w_router = F.in[8]; const float* w1 = F.in[10]; const float* w2 = F.in[12];
    constexpr int I_IN = 0, I_ATT = 8 * 16, I_RET = 16 * 16, I_OUT = 16 * 16, I_W1 = 16 * 32, I_W2 = 16 * 16;
    constexpr int NITEMS = I_IN + I_ATT + I_RET + I_OUT;
    for (int it = gw; it < NITEMS; it += NGW) {
        int r = it;
        if (r < I_ATT) { p0_transpose_item<0, 0>(w_att, 512, 1024, 1024, (bf16_t*)(F.ws + WS_WATT), nullptr, scr, r, F.lane); continue; } r -= I_ATT;
        if (r < I_RET) { p0_transpose_item<0, 0>(w_ret, 1024, 1024, 1024, (bf16_t*)(F.ws + WS_WRET), nullptr, scr, r, F.lane); continue; } r -= I_RET;
        p0_transpose_item<0, 0>(w_out, 1024, 1024, 1024, (bf16_t*)(F.ws + WS_WOUT), nullptr, scr, r, F.lane);
    }
    p0_quant_all(F, w1, w2, w_in, g_ffn, g_mix);
    unsigned* HBQ = (unsigned*)(F.dout + DO_HBQ); float* RS0 = (float*)(F.ws + WS_RS0);
    for (int m = 2 * gw; m < T_TOK; m += 2 * NGW) {
        const f32x4* xr = (const f32x4*)(x + (size_t)m * DM) + F.lane;
        f32x4 v[8]; float s0 = 0.f, s1 = 0.f;
#pragma unroll
        for (int j = 0; j < 8; ++j) v[j] = xr[64 * j];
#pragma unroll
        for (int j = 0; j < 4; ++j) { s0 += (v[j][0] * v[j][0] + v[j][1] * v[j][1]) + (v[j][2] * v[j][2] + v[j][3] * v[j][3]); s1 += (v[j + 4][0] * v[j + 4][0] + v[j + 4][1] * v[j + 4][1]) + (v[j + 4][2] * v[j + 4][2] + v[j + 4][3] * v[j + 4][3]); }
        const float r0 = 1.0f / sqrtf(wave_sum(s0) * (1.0f / DM) + NORM_EPS), r1 = 1.0f / sqrtf(wave_sum(s1) * (1.0f / DM) + NORM_EPS);
        float a0 = 0.f, a1 = 0.f;
#pragma unroll
        for (int j = 0; j < 4; ++j) { a0 = fmaxf(fmaxf(a0, fmaxf(fabsf(v[j][0]), fabsf(v[j][1]))), fmaxf(fabsf(v[j][2]), fabsf(v[j][3]))); a1 = fmaxf(fmaxf(a1, fmaxf(fabsf(v[j + 4][0]), fabsf(v[j + 4][1]))), fmaxf(fabsf(v[j + 4][2]), fabsf(v[j + 4][3]))); }
#pragma unroll
        for (int o = 1; o < 64; o <<= 1) { a0 = fmaxf(a0, __shfl_xor(a0, o)); a1 = fmaxf(a1, __shfl_xor(a1, o)); }
        const float q0i = a0 > 0.f ? 127.0f / a0 : 0.f, q1i = a1 > 0.f ? 127.0f / a1 : 0.f;
        if (F.lane == 0) { RS0[m] = r0 * a0 * (1.0f / 127.0f); RS0[m + 1] = r1 * a1 * (1.0f / 127.0f); }
        unsigned* oq = HBQ + (size_t)m * 256 + F.lane;
#pragma unroll
        for (int j = 0; j < 8; ++j) { const float qi = j < 4 ? q0i : q1i; const unsigned b0 = __float_as_uint(fmaf(v[j][0], qi, 12582912.0f)), b1 = __float_as_uint(fmaf(v[j][1], qi, 12582912.0f)), b2 = __float_as_uint(fmaf(v[j][2], qi, 12582912.0f)), b3 = __float_as_uint(fmaf(v[j][3], qi, 12582912.0f));
            oq[64 * j] = pack_lo4(b0, b1, b2, b3); }
    }
    const int gt = blockIdx.x * 512 + F.tid, NGT = F.G * 512;
    float* rope = (float*)(F.ws + WS_ROPE);
    for (int i = gt; i < SEQ * 64; i += NGT) {
        const int s = i >> 6, p = i & 63;
        const float inv = powf(10000.0f, -(float)(2 * p) / 128.0f);
        const float ang = (float)s * inv;
        float sn, cs; sincosf(ang, &sn, &cs);
        rope[i] = cs; rope[SEQ * 64 + i] = sn;
    }
    float* biasT = (float*)(F.ws + WS_BIAS);
    for (int i = gt; i < 12 * 132; i += NGT) {
        const int gh = i / 132, j = i % 132, g = gh >> 2;
        biasT[i] = (j <= 128) ? rel_bias[(int)T5B[g][j] * 12 + gh] * LOG2E : 0.0f;
    }
    float* wrl = (float*)(F.ws + WS_WRL);
    for (int i = gt; i < 1024 * 32; i += NGT) {
        const int c = i & 3, e = (i >> 2) & 31, g = (i >> 7) & 3, ii = i >> 9, k = 16 * ii + 4 * g + c;
        wrl[i] = g_ffn[k] * w_router[k * 32 + e];
    }
}

__device__ __forceinline__ void attn_phase(Frame& F, int g) {
    const int lg = (g == 0) ? 0 : (g == 1 ? 2 : 4), d = 1 << lg, nblk = (SEQ >> lg) >> 7;
    const bf16_t* AB = (const bf16_t*)(F.ws + DY_ATTBUF);
    bf16_t* ATT = (bf16_t*)(F.ws + DY_ATT);
    float* LSE = (float*)(F.ws + WS_LSE);
    const float* biasT = (const float*)(F.ws + WS_BIAS);
    LAS unsigned char* Kl = F.lds; LAS unsigned char* Vl = F.lds + 65536;
    LAS float* biasL = (LAS float*)(F.lds + LDS_AUX);
    const int lane = F.lane, w = F.wave, g4 = lane >> 4, l15 = lane & 15, q4 = l15 >> 2, p4 = lane & 3;
    u32x4 kreg[8], vreg[8]; bf16x8 qf[4];
#define ATT_DECODE(it_, blk_, r_, slot_, b_) const int blk_ = (it_) % nblk, r_ = ((it_) / nblk) % d, slot_ = ((it_) / (nblk * d)) & 3, b_ = (it_) / (nblk * d * 4)
#define ATT_PREFETCH(it_, halo_) do { ATT_DECODE(it_, pblk, pr, pslot, pb); const int pm0 = pblk * 128, phead = 4 * g + pslot; \
        const char* ub_ = (const char*)(AB + ((size_t)pb * SEQ + (size_t)pr * (SEQ >> lg)) * N_ATT + phead * 128);        \
        const char* uh_ = ub_ + (size_t)(pblk ? pm0 - 128 : 0) * N_ATT * 2;         \
        const char* uo_ = ub_ + (size_t)pm0 * N_ATT * 2; \
        _Pragma("unroll") for (int j = 0; j < 4; ++j) { if (halo_) { kreg[j] = *(const u32x4*)(uh_ + (size_t)j * 32 * N_ATT * 2 + 3072 + vo0); vreg[j] = *(const u32x4*)(uh_ + (size_t)j * 32 * N_ATT * 2 + 6144 + vo0); } } \
        _Pragma("unroll") for (int j = 0; j < 4; ++j) { kreg[4 + j] = *(const u32x4*)(uo_ + (size_t)j * 32 * N_ATT * 2 + 3072 + vo0); vreg[4 + j] = *(const u32x4*)(uo_ + (size_t)j * 32 * N_ATT * 2 + 6144 + vo0); } \
        } while (0)
#define ATT_PREFETCH_Q(it_) do { ATT_DECODE(it_, pblk, pr, pslot, pb); const int phead = 4 * g + pslot; \
        const char* uq_ = (const char*)(AB + ((size_t)pb * SEQ + (size_t)pr * (SEQ >> lg) + pblk * 128) * N_ATT + phead * 128); \
        __builtin_amdgcn_sched_barrier(0); \
        _Pragma("unroll") for (int s = 0; s < 4; ++s) qf[s] = *(const bf16x8*)(uq_ + qo0 + 64 * s); \
        __builtin_amdgcn_sched_barrier(0); } while (0)
    const unsigned vo0 = (unsigned)((int)(F.tid >> 4) * N_ATT + (int)(F.tid & 15) * 8) * 2u, qo0 = (unsigned)((16 * w + l15) * N_ATT + 8 * g4) * 2u;
    const unsigned ob0 = off_b(F.tid >> 4, F.tid & 15);
    const int IPW = (2048 + F.G - 1) / F.G, it0 = (int)blockIdx.x * IPW, it1 = (it0 + IPW < 2048) ? it0 + IPW : 2048;
    if (it0 < it1) { ATT_PREFETCH(it0, true); ATT_PREFETCH_Q(it0); }
    int bias_head = -1;
    for (int item = it0; item < it1; ++item) {
        ATT_DECODE(item, blk, r, slot, b);
        const int m0 = blk * 128, head = 4 * g + slot;
        const bool halo = (item == it0) || (blk == 0);
        __syncthreads();
        if (head != bias_head) { if (F.tid < 132) biasL[F.tid] = biasT[head * 132 + F.tid]; bias_head = head; }
#pragma unroll
        for (int j = 0; j < 8; ++j) { *(LAS u32x4*)(Kl + ob0 + 8192 * j) = kreg[j]; *(LAS u32x4*)(Vl + ob0 + 8192 * j) = vreg[j]; }
        const int qstep = m0 + 16 * w + l15;
        const size_t qrow = (size_t)b * SEQ + (size_t)qstep * d + r;
        bf16_t* orow = ATT + qrow * 512 + slot * 128 + 4 * g4;
        float lp = 0.f; u32x2 pvv[8];
        if (g > 0) {
            __builtin_amdgcn_sched_barrier(0);
            lp = LSE[qrow * 4 + slot];
#pragma unroll
            for (int dt = 0; dt < 8; ++dt) pvv[dt] = *(const u32x2*)(orow + 16 * dt);
            __builtin_amdgcn_sched_barrier(0);
        }
        if (item + 1 < it1) { const bool nhalo = ((item + 1) % nblk) == 0;
            if (!nhalo) {
#pragma unroll
                for (int j = 0; j < 4; ++j) { kreg[j] = kreg[4 + j]; vreg[j] = vreg[4 + j]; }
            }
            ATT_PREFETCH(item + 1, nhalo); }
        __syncthreads();
        f32x4 sacc[9];
#pragma unroll
        for (int tt = 0; tt < 9; ++tt) {
            sacc[tt] = (f32x4){0.f, 0.f, 0.f, 0.f};
#pragma unroll
            for (int s = 0; s < 4; ++s) {
                const bf16x8 kf = *(const LAS bf16x8*)(Kl + off_b(16 * (w + tt) + l15, 4 * s + g4));
                sacc[tt] = __builtin_amdgcn_mfma_f32_16x16x32_bf16(kf, qf[s], sacc[tt], 0, 0, 0);
            }
        }
        if (item + 1 < it1) ATT_PREFETCH_Q(item + 1);
        const int kmin = 128 - m0;
        float mx = -1e30f;
        int dbase = 128 + l15 - 4 * g4, kbase = 16 * w + 4 * g4;
        asm volatile("" : "+v"(dbase), "+v"(kbase));
#pragma unroll
        for (int tt = 0; tt < 9; ++tt)
#pragma unroll
            for (int rg = 0; rg < 4; ++rg) {
                const int dist = dbase - 16 * tt - rg, kidx = kbase + 16 * tt + rg;
                const bool valid = (dist >= 0) && (dist <= 128) && (kidx >= kmin);
                const int dc = dist < 0 ? 0 : (dist > 128 ? 128 : dist);
                const float v = valid ? sacc[tt][rg] + biasL[dc] : -1e30f;
                sacc[tt][rg] = v; mx = fmaxf(mx, v);
            }
        mx = xr_max(mx);
        float lsum = 0.f;
#pragma unroll
        for (int tt = 0; tt < 9; ++tt)
#pragma unroll
            for (int rg = 0; rg < 4; ++rg) { const float p = (sacc[tt][rg] > -1e29f) ? fast_exp2(sacc[tt][rg] - mx) : 0.f; sacc[tt][rg] = p; lsum += p; }
        lsum = xr_sum(lsum);
        f32x4 oacc[8];
#pragma unroll
        for (int dt = 0; dt < 8; ++dt) oacc[dt] = (f32x4){0.f, 0.f, 0.f, 0.f};
#pragma unroll
        for (int uu = 0; uu < 5; ++uu) {
            u32x4 pw; pw.x = pk2(sacc[2 * uu][0], sacc[2 * uu][1]); pw.y = pk2(sacc[2 * uu][2], sacc[2 * uu][3]);
            if (uu < 4) { pw.z = pk2(sacc[2 * uu + 1][0], sacc[2 * uu + 1][1]); pw.w = pk2(sacc[2 * uu + 1][2], sacc[2 * uu + 1][3]); } else { pw.z = 0u; pw.w = 0u; }
            const bf16x8 pf = __builtin_bit_cast(bf16x8, pw);
            const int r0 = 16 * (w + 2 * uu) + 4 * g4 + q4, r1 = (uu < 4) ? r0 + 16 : r0;
#pragma unroll
            for (int dt = 0; dt < 8; ++dt) {
                const s16x4 lo = tr_read(Vl + off_b(r0, 2 * dt + (p4 >> 1)) + 8 * (p4 & 1));
                const s16x4 hi = tr_read(Vl + off_b(r1, 2 * dt + (p4 >> 1)) + 8 * (p4 & 1));
                oacc[dt] = __builtin_amdgcn_mfma_f32_16x16x32_bf16(cat8(lo, hi), pf, oacc[dt], 0, 0, 0);
            }
        }
        const float rl = 1.0f / lsum;
        float lse = mx + __builtin_log2f(lsum);
        float wn = 1.0f, wp = 0.0f;
        if (g > 0) {
            const float M = fmaxf(lp, lse); const float en = fast_exp2(lse - M), ep = fast_exp2(lp - M), tot = en + ep;
            wn = en / tot; wp = ep / tot; lse = M + __builtin_log2f(tot);
        }
#pragma unroll
        for (int dt = 0; dt < 8; ++dt) {
            f32x4 o = oacc[dt] * (rl * wn);
            if (g > 0) { const u32x2 pv = pvv[dt]; o[0] += wp * bflo(pv.x); o[1] += wp * bfhi(pv.x); o[2] += wp * bflo(pv.y); o[3] += wp * bfhi(pv.y); }
            u32x2 ow; ow.x = pk2(o[0], o[1]); ow.y = pk2(o[2], o[3]);
            *(u32x2*)(orow + 16 * dt) = ow;
        }
        if (g4 == 0) LSE[qrow * 4 + slot] = lse;
    }
#undef ATT_DECODE
#undef ATT_PREFETCH
#undef ATT_PREFETCH_Q
}

__device__ __forceinline__ float ret_log2g(int h) { return __builtin_log2f(1.0f - __builtin_amdgcn_exp2f(-5.0f - (float)h)); }
__device__ __forceinline__ void ret_state_phase(Frame& F) {
    const bf16_t* RB = (const bf16_t*)(F.ws + DY_RETBUF);
    bf16_t* SR = (bf16_t*)(F.dout + DO_SR);
    const int lane = F.lane, w = F.wave, g4 = lane >> 4, l15 = lane & 15, q4 = l15 >> 2, p4 = lane & 3;
    for (int item = blockIdx.x; item < 256; item += F.G) {
        const int es = item & 3, h = (item >> 2) & 3, b = item >> 4;
        const float g128 = __builtin_amdgcn_exp2f(128.0f * ret_log2g(h));
        f32x4 acc[4];
#pragma unroll
        for (int et = 0; et < 4; ++et) acc[et] = (f32x4){0.f, 0.f, 0.f, 0.f};
        u32x4 kA[4], vA[2], kB[4], vB[2];
        const size_t rowbase = (size_t)b * SEQ;
#define RS_LOAD(kreg, vreg, n) do { __builtin_amdgcn_sched_barrier(0); \
            _Pragma("unroll") for (int j = 0; j < 4; ++j) { const int cidx = F.tid + 512 * j, jr = cidx >> 4, ch = cidx & 15; kreg[j] = *(const u32x4*)(RB + (rowbase + (n) * 128 + jr) * N_RET + 512 + h * 128 + ch * 8); } \
            _Pragma("unroll") for (int j = 0; j < 2; ++j) { const int cidx = F.tid + 512 * j, jr = cidx >> 3, ch = cidx & 7; vreg[j] = *(const u32x4*)(RB + (rowbase + (n) * 128 + jr) * N_RET + 1024 + h * 256 + es * 64 + ch * 8); } \
            __builtin_amdgcn_sched_barrier(0); } while (0)
#define RS_STORE(kreg, vreg, buf) do { \
            _Pragma("unroll") for (int j = 0; j < 4; ++j) { const int cidx = F.tid + 512 * j, jr = cidx >> 4, ch = cidx & 15; *(LAS u32x4*)(F.lds + (buf) * 65536 + off_b(jr, ch)) = kreg[j]; } \
            _Pragma("unroll") for (int j = 0; j < 2; ++j) { const int cidx = F.tid + 512 * j, jr = cidx >> 3, ch = cidx & 7; *(LAS u32x4*)(F.lds + (buf) * 65536 + 32768 + off_b(jr, ch)) = vreg[j]; } } while (0)
#define RS_STEP(n, kreg, vreg) do { const int buf = (n) & 1; \
            bf16_t* srow = SR + ((size_t)((b * 4 + h) * 32 + (n)) * 256 + es * 64 + l15) * 128 + 16 * w + 4 * g4; \
            _Pragma("unroll") for (int et = 0; et < 4; ++et) { u32x2 ow; ow.x = pk2(acc[et][0], acc[et][1]); ow.y = pk2(acc[et][2], acc[et][3]); *(u32x2*)(srow + (size_t)et * 16 * 128) = ow; } \
            const LAS unsigned char* Kb = F.lds + buf * 65536; const LAS unsigned char* Vb = Kb + 32768; \
            _Pragma("unroll") for (int ks = 0; ks < 4; ++ks) { const int j0 = 32 * ks + 8 * g4 + q4; \
                const s16x4 klo = tr_read(Kb + off_b(j0, 2 * w + (p4 >> 1)) + 8 * (p4 & 1)); const s16x4 khi = tr_read(Kb + off_b(j0 + 4, 2 * w + (p4 >> 1)) + 8 * (p4 & 1)); const bf16x8 kf = cat8(klo, khi); \
                _Pragma("unroll") for (int et = 0; et < 4; ++et) { \
                    const s16x4 vlo = tr_read(Vb + off_b(j0, 2 * et + (p4 >> 1)) + 8 * (p4 & 1)); const s16x4 vhi = tr_read(Vb + off_b(j0 + 4, 2 * et + (p4 >> 1)) + 8 * (p4 & 1)); \
                    acc[et] = __builtin_amdgcn_mfma_f32_16x16x32_bf16(kf, cat8(vlo, vhi), acc[et], 0, 0, 0); } } \
            _Pragma("unroll") for (int et = 0; et < 4; ++et) acc[et] *= g128; \
            if ((n) + 1 < 32) RS_STORE(kreg, vreg, buf ^ 1);             \
            if ((n) + 3 < 32) RS_LOAD(kreg, vreg, (n) + 3); \
            __syncthreads(); } while (0)
        __syncthreads();
        RS_LOAD(kA, vA, 0); RS_STORE(kA, vA, 0);
        RS_LOAD(kA, vA, 1); RS_LOAD(kB, vB, 2);
        __syncthreads();
#pragma unroll 1
        for (int n = 0; n < 32; n += 2) { RS_STEP(n, kA, vA); RS_STEP(n + 1, kB, vB); }
#undef RS_STEP
#undef RS_LOAD
#undef RS_STORE
    }
}
__device__ __forceinline__ void ret_out_phase(Frame& F) {
    const bf16_t* RB = (const bf16_t*)(F.ws + DY_RETBUF);
    const bf16_t* SR = (const bf16_t*)(F.dout + DO_SR);
    bf16_t* RETN = (bf16_t*)(F.dout + DO_RETN);
    const int lane = F.lane, w = F.wave, g4 = lane >> 4, l15 = lane & 15, q4 = l15 >> 2, p4 = lane & 3;
    LAS unsigned char* Vl = F.lds;
    LAS unsigned char* Rl = F.lds + 65536;
    for (int item = blockIdx.x; item < 2048; item += F.G) {
        const int n = item & 31, h = (item >> 5) & 3, b = item >> 7;
        const size_t rowbase = (size_t)b * SEQ + n * 128;
        __syncthreads();
#pragma unroll
        for (int j = 0; j < 8; ++j) {
            const int cidx = F.tid + 512 * j;
            { const int jr = cidx >> 5, ch = cidx & 31; const u32x4 v = *(const u32x4*)(RB + (rowbase + jr) * N_RET + 1024 + h * 256 + ch * 8);
              *(LAS u32x4*)(Vl + (ch >> 4) * 32768 + off_b(jr, ch & 15)) = v; }
            { const int er = cidx >> 4, ch = cidx & 15; const u32x4 v = *(const u32x4*)(SR + ((size_t)((b * 4 + h) * 32 + n) * 256 + er) * 128 + ch * 8);
              *(LAS u32x4*)(Rl + off_b(er, ch)) = v; }
        }
        const size_t qrow = rowbase + 16 * w + l15;
        bf16x8 qf[4];
#pragma unroll
        for (int s = 0; s < 4; ++s) qf[s] = *(const bf16x8*)(RB + qrow * N_RET + h * 128 + 32 * s + 8 * g4);
        f32x4 sacc[8];
#pragma unroll
        for (int hb = 0; hb < 2; ++hb) {
            bf16x8 kf[4][4];
#pragma unroll
            for (int t4 = 0; t4 < 4; ++t4) { const int tt = 4 * hb + t4, tc = tt <= w ? tt : w;
#pragma unroll
                for (int s = 0; s < 4; ++s) kf[t4][s] = *(const bf16x8*)(RB + (rowbase + 16 * tc + l15) * N_RET + 512 + h * 128 + 32 * s + 8 * g4); }
#pragma unroll
            for (int t4 = 0; t4 < 4; ++t4) { const int tt = 4 * hb + t4;
                f32x4 a = (f32x4){0.f, 0.f, 0.f, 0.f};
#pragma unroll
                for (int s = 0; s < 4; ++s) a = __builtin_amdgcn_mfma_f32_16x16x32_bf16(kf[t4][s], qf[s], a, 0, 0, 0);
                if (tt > w) a = (f32x4){0.f, 0.f, 0.f, 0.f};
                if (tt == w) {
#pragma unroll
                    for (int rg = 0; rg < 4; ++rg) if (4 * g4 + rg > l15) a[rg] = 0.f;
                }
                sacc[tt] = a;
            }
        }
        const bf16_t* grow = RB + qrow * N_RET + 2048 + h * 256 + 4 * g4;
        u32x2 gwv[16];
        __builtin_amdgcn_sched_barrier(0);
#pragma unroll
        for (int et = 0; et < 16; ++et) gwv[et] = *(const u32x2*)(grow + 16 * et);
        __builtin_amdgcn_sched_barrier(0);
        __syncthreads();
        f32x4 oacc[16];
#pragma unroll
        for (int et = 0; et < 16; ++et) oacc[et] = (f32x4){0.f, 0.f, 0.f, 0.f};
#pragma unroll
        for (int uu = 0; uu < 4; ++uu) {
            if (2 * uu <= w) {
                u32x4 pw; pw.x = pk2(sacc[2 * uu][0], sacc[2 * uu][1]); pw.y = pk2(sacc[2 * uu][2], sacc[2 * uu][3]);
                pw.z = pk2(sacc[2 * uu + 1][0], sacc[2 * uu + 1][1]); pw.w = pk2(sacc[2 * uu + 1][2], sacc[2 * uu + 1][3]);
                const bf16x8 pf = __builtin_bit_cast(bf16x8, pw);
                const int r0 = 32 * uu + 4 * g4 + q4, r1 = r0 + 16;
#pragma unroll
                for (int et = 0; et < 16; ++et) {
                    const LAS unsigned char* vb = Vl + (et >> 3) * 32768;
                    const s16x4 lo = tr_read(vb + off_b(r0, 2 * (et & 7) + (p4 >> 1)) + 8 * (p4 & 1));
                    const s16x4 hi = tr_read(vb + off_b(r1, 2 * (et & 7) + (p4 >> 1)) + 8 * (p4 & 1));
                    oacc[et] = __builtin_amdgcn_mfma_f32_16x16x32_bf16(cat8(lo, hi), pf, oacc[et], 0, 0, 0);
                }
            }
        }
#pragma unroll
        for (int et = 0; et < 16; ++et)
#pragma unroll
            for (int s = 0; s < 4; ++s) {
                const bf16x8 rf = *(const LAS bf16x8*)(Rl + off_b(16 * et + l15, 4 * s + g4));
                oacc[et] = __builtin_amdgcn_mfma_f32_16x16x32_bf16(rf, qf[s], oacc[et], 0, 0, 0);
            }
        float sm = 0.f;
#pragma unroll
        for (int et = 0; et < 16; ++et) sm += (oacc[et][0] + oacc[et][1]) + (oacc[et][2] + oacc[et][3]);
        sm = xr_sum(sm);
        const float mean = sm * (1.0f / 256.0f);
        float sq = 0.f;
#pragma unroll
        for (int et = 0; et < 16; ++et) { const f32x4 dv = oacc[et] - mean; sq += (dv[0] * dv[0] + dv[1] * dv[1]) + (dv[2] * dv[2] + dv[3] * dv[3]); }
        sq = xr_sum(sq);
        const float rstd = 1.0f / sqrtf(sq * (1.0f / 256.0f) + NORM_EPS);
        bf16_t* orow = RETN + qrow * 1024 + h * 256 + 4 * g4;
#pragma unroll
        for (int et = 0; et < 16; ++et) {
            const u32x2 gw = gwv[et];
            const f32x4 y = (oacc[et] - mean) * rstd;
            u32x2 ow; ow.x = pk2(y[0] * bflo(gw.x), y[1] * bfhi(gw.x)); ow.y = pk2(y[2] * bflo(gw.y), y[3] * bfhi(gw.y));
            *(u32x2*)(orow + 16 * et) = ow;
        }
    }
}

__device__ __forceinline__ void router_phase(Frame& F) {
    const float* X1 = (const float*)F.dout;
    const float* wrl = (const float*)(F.ws + WS_WRL);
    const float* b_router = F.in[9];
    float* RSTD = (float*)(F.ws + WS_RSTD);
    const float* stats = (const float*)(F.ws + WS_STATS);
    unsigned* X1Q = (unsigned*)(F.ws + DY_X1B);
    int* asg_e = (int*)(F.ws + WS_ASG); float* asg_w = (float*)(F.ws + WS_ASG + 1 * MiB); int* asg_idx = (int*)(F.ws + WS_ASG + 2 * MiB);
    unsigned* gcnt = (unsigned*)(F.ws + WS_CTL) + CW_GCNT;
    LAS f32x4* WL = (LAS f32x4*)F.lds;
    LAS unsigned* hist = (LAS unsigned*)(F.lds + LDS_AUX);
    LAS unsigned* basel = hist + 32;
    LAS unsigned char* lds_e = (LAS unsigned char*)(F.lds + LDS_AUX + 256);
    LAS unsigned short* lds_rank = (LAS unsigned short*)(F.lds + LDS_AUX + 1280);
    const int lane = F.lane, w = F.wave, g4 = lane >> 4, l15 = lane & 15;
    __syncthreads();
    for (int i = F.tid; i < 8192; i += 512) WL[i] = ((const f32x4*)wrl)[i];
    if (F.tid < 32) hist[F.tid] = 0u;
    __syncthreads();
    for (int tb = blockIdx.x; tb < 256; tb += F.G) {
        const int half = tb >> 8;
#pragma unroll 1
        for (int it = 0; it < 2; ++it) {
            const int rg = 2 * w + it, row0 = tb * 256 + rg * 16;
            const float* xr = X1 + (size_t)(row0 + l15) * DM + 4 * g4;
            f32x4 acc0 = {0.f, 0.f, 0.f, 0.f}, acc1 = {0.f, 0.f, 0.f, 0.f};
            float ss, amax;
            { const f32x4* sp = (const f32x4*)(stats + ((size_t)(row0 + l15) * 16 + 4 * g4) * 2); const f32x4 s0 = sp[0], s1 = sp[1];
              ss = (s0[0] + s0[2]) + (s1[0] + s1[2]); amax = fmaxf(fmaxf(s0[1], s0[3]), fmaxf(s1[1], s1[3])); }
            ss = xr_sum(ss);
            const float rs = 1.0f / sqrtf(ss * (1.0f / DM) + NORM_EPS);
            amax = xr_max(amax);
            const float qinv = amax > 0.f ? 127.0f / amax : 0.f;
            if (lane < 16) RSTD[row0 + lane] = rs * amax * (1.0f / 127.0f);
            f32x4 xa[8], xb[8];
#define RT_LOAD(x, ib) do { __builtin_amdgcn_sched_barrier(0); _Pragma("unroll") for (int ii = 0; ii < 8; ++ii) x[ii] = *(const f32x4*)(xr + 16 * (8 * (ib) + ii)); __builtin_amdgcn_sched_barrier(0); } while (0)
#define RT_COMP(x, ib) do { _Pragma("unroll") for (int ii = 0; ii < 8; ++ii) { const int i = 8 * (ib) + ii; \
                const f32x4 w0 = WL[(i * 4 + g4) * 32 + l15], w1 = WL[(i * 4 + g4) * 32 + 16 + l15]; \
                _Pragma("unroll") for (int c = 0; c < 4; ++c) { \
                    acc0 = __builtin_amdgcn_mfma_f32_16x16x4f32(x[ii][c], w0[c], acc0, 0, 0, 0); acc1 = __builtin_amdgcn_mfma_f32_16x16x4f32(x[ii][c], w1[c], acc1, 0, 0, 0); } \
                const unsigned q0 = __float_as_uint(fmaf(x[ii][0], qinv, 12582912.0f)), q1 = __float_as_uint(fmaf(x[ii][1], qinv, 12582912.0f)), q2 = __float_as_uint(fmaf(x[ii][2], qinv, 12582912.0f)), q3 = __float_as_uint(fmaf(x[ii][3], qinv, 12582912.0f)); \
                X1Q[(size_t)(row0 + l15) * 256 + 4 * i + g4] = pack_lo4(q0, q1, q2, q3); } } while (0)
            RT_LOAD(xa, 0);
#pragma unroll 1
            for (int ib = 0; ib < 8; ib += 2) {
                RT_LOAD(xb, ib + 1);
                RT_COMP(xa, ib);
                if (ib + 2 < 8) RT_LOAD(xa, ib + 2);
                RT_COMP(xb, ib + 1);
            }
#undef RT_LOAD
#undef RT_COMP
            const float b0 = b_router[l15], b1 = b_router[16 + l15];
#pragma unroll
            for (int rgi = 0; rgi < 4; ++rgi) {
                const float rr = __shfl(rs, 4 * g4 + rgi);
                float v0 = acc0[rgi] * rr + b0, v1 = acc1[rgi] * rr + b1;
                float pv[4]; int pi[4];
#pragma unroll
                for (int pk = 0; pk < 4; ++pk) {
                    float bv; int bi;
                    if (v0 >= v1) { bv = v0; bi = l15; } else { bv = v1; bi = 16 + l15; }
#pragma unroll
                    for (int o = 1; o < 16; o <<= 1) {
                        const float ov = __shfl_xor(bv, o); const int oi = __shfl_xor(bi, o);
                        if (ov > bv || (ov == bv && oi < bi)) { bv = ov; bi = oi; }
                    }
                    pv[pk] = bv; pi[pk] = bi;
                    if (bi == l15) v0 = -3.0e38f;
                    if (bi == 16 + l15) v1 = -3.0e38f;
                }
                if (l15 == 0) {
                    const float e1 = __expf(pv[1] - pv[0]), e2 = __expf(pv[2] - pv[0]), e3 = __expf(pv[3] - pv[0]);
                    const float inv = 1.0f / (1.0f + e1 + e2 + e3);
                    const float gt[4] = {inv, e1 * inv, e2 * inv, e3 * inv};
                    const int tl = rg * 16 + 4 * g4 + rgi, tok = tb * 256 + tl;
#pragma unroll
                    for (int pk = 0; pk < 4; ++pk) {
                        const unsigned rk = atomicAdd((unsigned*)&hist[pi[pk]], 1u);
                        lds_e[tl * 4 + pk] = (unsigned char)pi[pk]; lds_rank[tl * 4 + pk] = (unsigned short)rk;
                        asg_w[tok * 4 + pk] = gt[pk];
                    }
                }
            }
        }
        __syncthreads();
        if (F.tid < 32) { basel[F.tid] = atomicAdd(&gcnt[half * 32 + F.tid], hist[F.tid]); }
        __syncthreads();
        for (int a = F.tid; a < 1024; a += 512) {
            const int e = lds_e[a];
            asg_e[tb * 1024 + a] = e; asg_idx[tb * 1024 + a] = (int)(basel[e] + lds_rank[a]);
        }
        __syncthreads();
        if (F.tid < 32) hist[F.tid] = 0u;
        __syncthreads();
    }
}
__device__ __forceinline__ void scatter_phase(Frame& F) {
    const unsigned* gcnt = (const unsigned*)(F.ws + WS_CTL) + CW_GCNT;
    const float* RSTD = (const float*)(F.ws + WS_RSTD);
    const int* asg_e = (const int*)(F.ws + WS_ASG); const float* asg_w = (const float*)(F.ws + WS_ASG + 1 * MiB); const int* asg_idx = (const int*)(F.ws + WS_ASG + 2 * MiB);
    int* asg_pos = (int*)(F.ws + WS_ASG + 3 * MiB);
    int* tile_expert = (int*)(F.ws + WS_TILE);
    LAS int* seg = (LAS int*)(F.lds + LDS_AUX);
    LAS int* cntl = seg + 64;
    __syncthreads();
    if (F.tid < 64) {
        const int c = (int)__hip_atomic_load(&gcnt[F.tid], __ATOMIC_RELAXED, __HIP_MEMORY_SCOPE_AGENT), pad = (c + 255) & ~255;
        int run = pad;
#pragma unroll
        for (int o = 1; o < 32; o <<= 1) { const int t = __shfl_up(run, o, 32); if ((F.tid & 31) >= o) run += t; }
        seg[F.tid] = run - pad; cntl[F.tid] = c;
        if (blockIdx.x == 0 && (F.tid & 31) == 31) tile_expert[2 * HALF_TILES + (F.tid >> 5)] = run >> 8;
    }
    __syncthreads();
    const int gt = blockIdx.x * 512 + F.tid, NGT = F.G * 512;
    for (int a = gt; a < T_TOK * 4; a += NGT) {
        const int tok = a >> 2, half = tok >> 16, e = asg_e[a];
        const int pos = seg[half * 32 + e] + asg_idx[a];
        int* tokS = (int*)(F.ws + WS_SORT + (size_t)half * 3 * HALF_ROWS * 4); float* wS = (float*)(tokS + HALF_ROWS); float* rS = wS + HALF_ROWS;
        tokS[pos] = tok; wS[pos] = asg_w[a]; rS[pos] = RSTD[tok]; asg_pos[a] = pos;
    }
    for (int j = blockIdx.x; j < 32; j += F.G) {
        const int half = j >> 5, e = j & 31, s0 = seg[j], c = cntl[j], pe = (c + 255) & ~255;
        int* tokS = (int*)(F.ws + WS_SORT + (size_t)half * 3 * HALF_ROWS * 4); float* wS = (float*)(tokS + HALF_ROWS); float* rS = wS + HALF_ROWS;
        for (int i = c + F.tid; i < pe; i += 512) { tokS[s0 + i] = half * HALF_TOK; wS[s0 + i] = 0.f; rS[s0 + i] = 0.f; }
        for (int t = F.tid; t < (pe >> 8); t += 512) tile_expert[half * HALF_TILES + (s0 >> 8) + t] = e;
    }
}
__device__ __forceinline__ void final_phase(Frame& F, int half) {
    float* X1 = (float*)F.dout;
    const unsigned char* Y = (const unsigned char*)(F.ws + DY_Y);
    const float* YS = (const float*)(F.ws + DY_YS);
    const int* asg_pos = (const int*)(F.ws + WS_ASG + 3 * MiB);
    const float* gfin = F.in[14];
    const int gw = blockIdx.x * 8 + F.wave, NGW = F.G * 8, wsl = (F.lane >> 3) & 3;
    const int mbeg = half * HALF_TOK + 2 * gw, mend = (half + 1) * HALF_TOK;
    f32x4 gfv[4];
#pragma unroll
    for (int j = 0; j < 4; ++j) gfv[j] = *((const f32x4*)gfin + F.lane + 64 * j);
    int pos[2][4];
    if (mbeg < mend) {
#pragma unroll
        for (int r = 0; r < 2; ++r)
#pragma unroll
            for (int k = 0; k < 4; ++k) pos[r][k] = asg_pos[(mbeg + r) * 4 + k];
    }
    for (int m0 = mbeg; m0 < mend; m0 += 2 * NGW) {
        f32x4 v[2][4]; unsigned yw[2][4][4]; float ys[2][4][4]; int posn[2][4];
#pragma unroll
        for (int r = 0; r < 2; ++r)
#pragma unroll
            for (int j = 0; j < 4; ++j) {
                v[r][j] = ((const f32x4*)(X1 + (size_t)(m0 + r) * DM) + F.lane)[64 * j];
#pragma unroll
                for (int k = 0; k < 4; ++k) { yw[r][j][k] = *((const unsigned*)(Y + (size_t)pos[r][k] * DM) + F.lane + 64 * j); ys[r][j][k] = YS[(size_t)pos[r][k] * 16 + j * 4 + wsl]; }
            }
        __builtin_amdgcn_sched_barrier(0);
        { const int mn = (m0 + 2 * NGW < mend) ? m0 + 2 * NGW : m0;
#pragma unroll
          for (int r = 0; r < 2; ++r)
#pragma unroll
            for (int k = 0; k < 4; ++k) posn[r][k] = asg_pos[(mn + r) * 4 + k]; }
        __builtin_amdgcn_sched_barrier(0);
        float s[2] = {0.f, 0.f};
#pragma unroll
        for (int r = 0; r < 2; ++r)
#pragma unroll
            for (int j = 0; j < 4; ++j) {
                float off = 0.f;
#pragma unroll
                for (int k = 0; k < 4; ++k) { const unsigned wq = yw[r][j][k]; const float sc = ys[r][j][k]; off += sc;
                    v[r][j][0] = fmaf((float)(wq & 255u), sc, v[r][j][0]); v[r][j][1] = fmaf((float)((wq >> 8) & 255u), sc, v[r][j][1]);
                    v[r][j][2] = fmaf((float)((wq >> 16) & 255u), sc, v[r][j][2]); v[r][j][3] = fmaf((float)(wq >> 24), sc, v[r][j][3]); }
                v[r][j] -= 128.0f * off;
                s[r] += (v[r][j][0] * v[r][j][0] + v[r][j][1] * v[r][j][1]) + (v[r][j][2] * v[r][j][2] + v[r][j][3] * v[r][j][3]);
            }
#pragma unroll
        for (int r = 0; r < 2; ++r) {
            const float rstd = 1.0f / sqrtf(wave_sum(s[r]) * (1.0f / DM) + NORM_EPS);
            f32x4* xr = (f32x4*)(X1 + (size_t)(m0 + r) * DM) + F.lane;
#pragma unroll
            for (int j = 0; j < 4; ++j) xr[64 * j] = v[r][j] * rstd * gfv[j];
        }
#pragma unroll
        for (int r = 0; r < 2; ++r)
#pragma unroll
            for (int k = 0; k < 4; ++k) pos[r][k] = posn[r][k];
    }
}

constexpr int N_PHASES = 15;
__global__ void __launch_bounds__(512, 2) mk_fwd(Args args) {
    extern __shared__ __attribute__((aligned(16))) unsigned char lds_raw[];
    Frame F;
    F.lds = (LAS unsigned char*)lds_raw;
    F.tid = threadIdx.x; F.lane = F.tid & 63; F.wave = __builtin_amdgcn_readfirstlane(F.tid >> 6); F.G = gridDim.x;
    F.ws = args.ws; F.dout = (unsigned char*)args.out;
#pragma unroll
    for (int i = 0; i < 15; ++i) F.in[i] = args.in[i];
    volatile LAS unsigned* MISC = (volatile LAS unsigned*)(F.lds + LDS_MISC);
    if (F.tid < 64) MISC[F.tid] = 0u;
    __syncthreads();
    XcdBarrier bar; bar.bar = (unsigned*)(F.ws + WS_CTL) + CW_BAR; bar.x = 0; bar.st = nullptr;
    if (!MK_PER_PHASE) bar = xcd_barrier_post((unsigned*)(F.ws + WS_CTL) + CW_BAR, MISC + 8);
    const int lo = args.ph_lo, hi = args.ph_hi;
#define IN(k) (lo <= (k) && (k) < hi)
#define SEAM(k) do { if (IN(k) && IN((k) + 1)) xcd_barrier(bar); } while (0)
    using namespace pg8;
    const float* rope = (const float*)(F.ws + WS_ROPE);
    const int c = (int)blockIdx.x;

    if (IN(0)) { p0_prologue(F); } SEAM(0);
    if (IN(1)) {
        SchedDense S{T_TOK / 256, N_ATT / 256, F.G, c, 512, (const char*)(F.ws + WS_WINQ)};
        EpiProj<0> E{(bf16_t*)(F.ws + DY_ATTBUF), N_ATT, rope, (const float*)(F.ws + WS_RS0), (const float*)(F.ws + WS_SWIN), 1};
        gemm_phase<EpiProj<0>, SchedDense, true>(F.lds, (const char*)(F.dout + DO_HBQ), S, E);
    } SEAM(1);
    if (IN(2)) { attn_phase(F, 0); } SEAM(2);
    if (IN(3)) { attn_phase(F, 1); } SEAM(3);
    if (IN(4)) { attn_phase(F, 2); } SEAM(4);
    if (IN(5)) {
        { SchedDense S{T_TOK / 256, N_GATE / 256, F.G, c, 512, (const char*)(F.ws + WS_WINQ) + (size_t)7680 * 1024};
          EpiProj<3> E{(bf16_t*)(F.ws + DY_GATEBUF), N_GATE, rope, (const float*)(F.ws + WS_RS0), (const float*)(F.ws + WS_SWIN) + 7680, 0};
          gemm_phase<EpiProj<3>, SchedDense, true>(F.lds, (const char*)(F.dout + DO_HBQ), S, E); }
        { SchedDense S{T_TOK / 256, N_RET / 256, F.G, c, 512, (const char*)(F.ws + WS_WINQ) + (size_t)4608 * 1024};
          EpiProj<2> E{(bf16_t*)(F.ws + DY_RETBUF), N_RET, rope, (const float*)(F.ws + WS_RS0), (const float*)(F.ws + WS_SWIN) + 4608, 0};
          gemm_phase<EpiProj<2>, SchedDense, true>(F.lds, (const char*)(F.dout + DO_HBQ), S, E); }
    } SEAM(5);
    if (IN(6)) { ret_state_phase(F); } SEAM(6);
    if (IN(7)) { ret_out_phase(F); } SEAM(7);
    if (IN(8)) {
        { SchedDense S{T_TOK / 256, 4, F.G, c, 512, (const char*)(F.ws + WS_WATT)};
          EpiM1 E{(bf16_t*)(F.ws + DY_M1), (const unsigned char*)(F.ws + DY_GATEBUF)};
          gemm_phase(F.lds, (const char*)(F.ws + DY_ATT), S, E); }
        VM_WAIT(); __syncthreads();
        { SchedDense S{T_TOK / 256, 4, F.G, c, 1024, (const char*)(F.ws + WS_WRET)};
          EpiMerge E{(bf16_t*)(F.ws + DY_MERGED), (const unsigned char*)(F.ws + DY_GATEBUF), (const bf16_t*)(F.ws + DY_M1)};
          gemm_phase(F.lds, (const char*)(F.dout + DO_RETN), S, E); }
    } SEAM(8);
    if (IN(9)) {
        SchedDense S{T_TOK / 256, 4, F.G, c, 1024, (const char*)(F.ws + WS_WOUT)};
        EpiX1 E{F.in[0], (float*)F.dout, (float*)(F.ws + WS_STATS)};
        gemm_phase(F.lds, (const char*)(F.ws + DY_MERGED), S, E);
    } SEAM(9);
    if (IN(10)) { router_phase(F); } SEAM(10);
    if (IN(11)) { scatter_phase(F); } SEAM(11);
#define MOE_UP(half) do { \
        const int* tileE = (const int*)(F.ws + WS_TILE) + (half) * HALF_TILES; const int ntl = __builtin_amdgcn_readfirstlane(((const int*)(F.ws + WS_TILE))[2 * HALF_TILES + (half)]); \
        const int* tokS = (const int*)(F.ws + WS_SORT + (size_t)(half) * 3 * HALF_ROWS * 4); \
        SchedMoE S{ntl, 8, F.G, c, 512, (const char*)(F.ws + WS_W1), (size_t)2048 * 1024, tileE, tokS}; \
        EpiSwiglu E{(bf16_t*)(F.ws + DY_ACT), F.in[11], (const float*)(tokS + 2 * HALF_ROWS), (const float*)(F.ws + WS_SW1)}; \
        gemm_phase<EpiSwiglu, SchedMoE, true>(F.lds, (const char*)(F.ws + DY_X1B), S, E); } while (0)
#define MOE_DOWN(half) do { \
        const int* tileE = (const int*)(F.ws + WS_TILE) + (half) * HALF_TILES; const int ntl = __builtin_amdgcn_readfirstlane(((const int*)(F.ws + WS_TILE))[2 * HALF_TILES + (half)]); \
        const int* tokS = (const int*)(F.ws + WS_SORT + (size_t)(half) * 3 * HALF_ROWS * 4); \
        SchedMoE S{ntl, 4, F.G, c, 512, (const char*)(F.ws + WS_W2), (size_t)1024 * 1024, tileE, nullptr}; \
        EpiDown E{(unsigned char*)(F.ws + DY_Y), (float*)(F.ws + DY_YS), F.in[13], (const float*)(tokS + HALF_ROWS), (const float*)(F.ws + WS_SW2)}; \
        gemm_phase<EpiDown, SchedMoE, true>(F.lds, (const char*)(F.ws + DY_ACT), S, E); } while (0)
    if (IN(12)) { MOE_UP(0); } SEAM(12);
    if (IN(13)) { MOE_DOWN(0); } SEAM(13);
    if (IN(14)) { final_phase(F, 0); }
#undef IN
#undef SEAM
}


extern "C" void kernel_launch(void* const* d_in, const int* in_sizes, int n_in, void* d_out, int out_size, void* d_ws, size_t ws_size, hipStream_t stream) {
    static int grid = 0;
    if (grid == 0) {
        if (n_in != 15 || out_size != T_TOK * DM || ws_size < WS_END) { fprintf(stderr, "kernel_launch: unexpected shapes (n_in %d out %d ws %zu)\n", n_in, out_size, ws_size); grid = -1; return; }
        int dev = 0, cus = 0, per_cu = 0;
        if (hipGetDevice(&dev) != hipSuccess || hipDeviceGetAttribute(&cus, hipDeviceAttributeMultiprocessorCount, dev) != hipSuccess) { grid = -1; return; }
        if (hipFuncSetAttribute((const void*)mk_fwd, hipFuncAttributeMaxDynamicSharedMemorySize, LDS_BYTES) != hipSuccess) { fprintf(stderr, "kernel_launch: hipFuncSetAttribute failed\n"); grid = -1; return; }
        if (hipOccupancyMaxActiveBlocksPerMultiprocessor(&per_cu, (const void*)mk_fwd, 512, LDS_BYTES) != hipSuccess || per_cu < 1) { fprintf(stderr, "kernel_launch: occupancy query says %d\n", per_cu); }
        (void)hipGetLastError();
        grid = cus;
    }
    if (grid < 0) return;
    (void)hipMemsetAsync((char*)d_ws + WS_CTL, 0, CTL_BYTES, stream);
    Args a{};
    for (int i = 0; i < 15; ++i) a.in[i] = (const float*)d_in[i];
    a.out = (float*)d_out; a.ws = (unsigned char*)d_ws;
#if MK_PER_PHASE
    for (int p = 0; p < N_PHASES; ++p) { a.ph_lo = p; a.ph_hi = p + 1; hipLaunchKernelGGL(mk_fwd, dim3(grid), dim3(512), LDS_BYTES, stream, a); }
#else
    a.ph_lo = 0; a.ph_hi = N_PHASES;
    hipLaunchKernelGGL(mk_fwd, dim3(grid), dim3(512), LDS_BYTES, stream, a);
#endif
}
```
